# Optimizing an MI355X kernel written in HIP

```python
import math
import jax, jax.numpy as jnp
from jax import lax
import numpy as np

D_MODEL = 1024
BATCH = 1
SEQ = 16384
DEPTH = 1

HEAD_DIM = 64
HEADS_PER_GROUP = D_MODEL // 128
ATT_GROUPS = ((128, 1), (512, 4), (2048, 16))
N_GROUPS = 3
ATT_QKV_WIDTH = N_GROUPS * HEADS_PER_GROUP * HEAD_DIM
ATT_OUT_WIDTH = HEADS_PER_GROUP * HEAD_DIM
CONV_WIDTH = D_MODEL
CONV_K = 3
DN_ALPHA = (2.0 * DEPTH) ** 0.25
DN_BETA = (8.0 * DEPTH) ** -0.25
LN_EPS = 1e-5
SECTION_WIDTHS = (ATT_QKV_WIDTH, ATT_QKV_WIDTH, ATT_QKV_WIDTH, ATT_OUT_WIDTH,
                  CONV_WIDTH, CONV_WIDTH, CONV_WIDTH, CONV_WIDTH, 2 * D_MODEL)
IN_WIDTH = 4 * ATT_QKV_WIDTH // 4 * 3 + ATT_OUT_WIDTH + 4 * CONV_WIDTH + 2 * D_MODEL
V_START = 2 * ATT_QKV_WIDTH
V_END = 3 * ATT_QKV_WIDTH

kernel_name = "hybrid_conv_dilated_swa_deepnorm"


def layer_norm(x, g, b):
    xf = x.astype(jnp.float32)
    mu = jnp.mean(xf, axis=-1, keepdims=True)
    var = jnp.mean(jnp.square(xf - mu), axis=-1, keepdims=True)
    y = (xf - mu) * lax.rsqrt(var + LN_EPS) * g.astype(jnp.float32) + b.astype(jnp.float32)
    return y.astype(x.dtype)


def causal_short_conv(u, w):
    s = u.shape[1]
    up = jnp.pad(u, ((0, 0), (CONV_K - 1, 0), (0, 0)))
    y = w[0] * up[:, 0:s]
    for j in range(1, CONV_K):
        y = y + w[j] * up[:, j:j + s]
    return y


def dilated_window_attention(q, k, v, window, dilation):
    b, s, h, dh = q.shape
    n_win = window // dilation
    blk = n_win
    length = s // dilation
    n_blk = -(-length // blk)
    pad = n_blk * blk - length

    def to_blocks(t):
        t = t.reshape(b, length, dilation, h, dh).transpose(0, 2, 1, 3, 4)
        t = jnp.pad(t, ((0, 0), (0, 0), (0, pad), (0, 0), (0, 0)))
        return t.reshape(b, dilation, n_blk, blk, h, dh)

    def with_prev(t):
        prev = jnp.pad(t, ((0, 0), (0, 0), (1, 0), (0, 0), (0, 0), (0, 0)))[:, :, :-1]
        return jnp.concatenate([prev, t], axis=3)

    qb = to_blocks(q)
    kc = with_prev(to_blocks(k))
    vc = with_prev(to_blocks(v))

    scores = jnp.einsum('brnqhd,brnkhd->brnhqk', qb, kc,
                        preferred_element_type=jnp.float32) * (dh ** -0.5)
    q_idx = jnp.arange(blk)[:, None]
    k_idx = jnp.arange(2 * blk)[None, :] - blk
    rel = q_idx - k_idx
    blk_start = (jnp.arange(n_blk) * blk)[:, None, None]
    valid = (rel >= 0) & (rel <= n_win) & (blk_start + k_idx >= 0)
    scores = jnp.where(valid[:, None], scores, -jnp.inf)
    lse = jax.nn.logsumexp(scores, axis=-1)
    probs = jnp.exp(scores - lse[..., None])
    out = jnp.einsum('brnhqk,brnkhd->brnqhd', probs, vc.astype(jnp.float32))

    def from_blocks(t):
        rest = t.shape[4:]
        t = t.reshape((b, dilation, n_blk * blk) + rest)[:, :, :length]
        return jnp.swapaxes(t, 1, 2).reshape((b, s) + rest)

    return from_blocks(out), from_blocks(lse.transpose(0, 1, 2, 4, 3))


def hybrid_layer(x, w_in, conv_w, w_conv_out, w_att_out, b_gate, w_o, ln_g, ln_b):
    b, s, _ = x.shape
    proj = jnp.einsum('bsd,de->bse', x, w_in)
    idx = np.cumsum(SECTION_WIDTHS)[:-1]
    q, k, v, g_att, h_c, b_c, c_c, g_conv, gate_logits = jnp.split(proj, idx, axis=-1)

    q = q.reshape(b, s, N_GROUPS, HEADS_PER_GROUP, HEAD_DIM)
    k = k.reshape(b, s, N_GROUPS, HEADS_PER_GROUP, HEAD_DIM)
    v = v.reshape(b, s, N_GROUPS, HEADS_PER_GROUP, HEAD_DIM)
    outs, lses = [], []
    for gi, (window, dilation) in enumerate(ATT_GROUPS):
        o, l = dilated_window_attention(q[:, :, gi], k[:, :, gi], v[:, :, gi], window, dilation)
        outs.append(o)
        lses.append(l)
    outs = jnp.stack(outs)
    mix = jax.nn.softmax(jnp.stack(lses), axis=0)
    att = jnp.sum(mix[..., None] * outs, axis=0).reshape(b, s, ATT_OUT_WIDTH).astype(x.dtype)
    y_att = jnp.einsum('bse,ed->bsd', att * jax.nn.silu(g_att), w_att_out)

    conv = causal_short_conv(c_c * h_c, conv_w)
    y_conv = jnp.einsum('bse,ed->bsd', (b_c * conv) * jax.nn.silu(g_conv), w_conv_out)

    gates = jax.nn.sigmoid(gate_logits + b_gate)
    g_c, g_a = jnp.split(gates, 2, axis=-1)
    merged = g_c * y_conv + g_a * y_att
    out = jnp.einsum('bsd,de->bse', merged, w_o)

    return layer_norm(DN_ALPHA * x + out, ln_g, ln_b)


def setup_inputs(seed: int = 0) -> dict:
    key = jax.random.key(seed)
    ks = jax.random.split(key, 10)
    x = jax.random.normal(ks[0], (BATCH, SEQ, D_MODEL), jnp.float32)
    w_in = jax.random.normal(ks[1], (DEPTH, D_MODEL, IN_WIDTH), jnp.float32) * D_MODEL ** -0.5
    w_in = w_in.at[:, :, V_START:V_END].multiply(DN_BETA)
    conv_w = jax.random.normal(ks[2], (DEPTH, CONV_K, CONV_WIDTH), jnp.float32) * CONV_K ** -0.5
    w_conv_out = jax.random.normal(ks[3], (DEPTH, CONV_WIDTH, D_MODEL), jnp.float32) * (CONV_WIDTH ** -0.5 * DN_BETA)
    w_att_out = jax.random.normal(ks[4], (DEPTH, ATT_OUT_WIDTH, D_MODEL), jnp.float32) * (ATT_OUT_WIDTH ** -0.5 * DN_BETA)
    b_gate = jax.random.normal(ks[5], (DEPTH, 2 * D_MODEL), jnp.float32) * 0.1
    w_o = jax.random.normal(ks[6], (DEPTH, D_MODEL, D_MODEL), jnp.float32) * (D_MODEL ** -0.5 * DN_BETA)
    ln_g = 1.0 + 0.02 * jax.random.normal(ks[7], (DEPTH, D_MODEL), jnp.float32)
    ln_b = 0.02 * jax.random.normal(ks[8], (DEPTH, D_MODEL), jnp.float32)
    return {"x": x, "w_in": w_in, "conv_w": conv_w, "w_conv_out": w_conv_out,
            "w_att_out": w_att_out, "b_gate": b_gate, "w_o": w_o, "ln_g": ln_g, "ln_b": ln_b}


def reference(x, w_in, conv_w, w_conv_out, w_att_out, b_gate, w_o, ln_g, ln_b):
    h = x
    for layer in range(DEPTH):
        h = hybrid_layer(h, w_in[layer], conv_w[layer], w_conv_out[layer], w_att_out[layer],
                         b_gate[layer], w_o[layer], ln_g[layer], ln_b[layer])
    return h
```

```cpp
#include <hip/hip_runtime.h>
#include <hip/hip_cooperative_groups.h>
#include <cstdio>
#include <cstdint>
namespace cg = cooperative_groups;

#ifndef N_LAUNCH_MODE
#define N_LAUNCH_MODE 1
#endif

#define LAS __attribute__((address_space(3)))
#define GAS __attribute__((address_space(1)))
typedef unsigned short bf16_t;
typedef short bf16x8 __attribute__((ext_vector_type(8)));
typedef float f32x4 __attribute__((ext_vector_type(4)));
typedef float f32x2 __attribute__((ext_vector_type(2)));
typedef float f32x16 __attribute__((ext_vector_type(16)));
typedef unsigned u32x4 __attribute__((ext_vector_type(4)));
typedef unsigned u32x2 __attribute__((ext_vector_type(2)));
typedef __bf16 bf16x2_t __attribute__((ext_vector_type(2)));

constexpr int S = 16384, D = 1024, NIN = 11264, QKVW = 1536, AW = 512;
constexpr float LN_EPS = 1e-5f;
constexpr float DN_ALPHA = 1.189207115002721f;
constexpr float C2 = 0.125f * 1.4426950408889634f;
constexpr int NPH = 8;

constexpr size_t MiB = 1u << 20;
constexpr size_t WS_XB = 0;
constexpr size_t WS_WIN = 32 * MiB;
constexpr size_t WS_WY = 54 * MiB;
constexpr size_t WS_WO = 57 * MiB;
constexpr size_t WS_QK = 59 * MiB;
constexpr size_t WS_VT = 155 * MiB;
constexpr size_t WS_OG = 203 * MiB;
constexpr size_t WS_LSE = 251 * MiB;
constexpr size_t WS_END = 253 * MiB;
constexpr size_t WS_SG = WS_QK, WS_RATIO = WS_QK + 16 * MiB, WS_GA = WS_QK + 48 * MiB, WS_A2 = WS_VT, WS_MERGED = WS_XB;

__device__ __forceinline__ unsigned cvt_pk(float lo, float hi) { f32x2 v = {lo, hi}; bf16x2_t b = __builtin_convertvector(v, bf16x2_t); return __builtin_bit_cast(unsigned, b); }
__device__ __forceinline__ float bf_lo(unsigned w) { return __uint_as_float(w << 16); }
__device__ __forceinline__ float bf_hi(unsigned w) { return __uint_as_float(w & 0xffff0000u); }
__device__ __forceinline__ float sigmoidf_(float x) { return __builtin_amdgcn_rcpf(1.0f + __expf(-x)); }
__device__ __forceinline__ float siluf_(float x) { return x * sigmoidf_(x); }

namespace pg8 {
constexpr int BM = 256, BK = 64, HALF = 128, HTB = HALF * BK * 2, STAGE_BYTES = 8 * HTB, NXCD = 8, WGM = 8;
__host__ __device__ __forceinline__ int lds_byte(int r, int c) { const int st = (r >> 4) * 2 + (c >> 5), rr = r & 15, cc = c & 31, ob = rr * 64 + cc * 2; return st * 1024 + (ob ^ (((ob >> 9) & 1) << 5)); }
__host__ __device__ __forceinline__ void stage_rc(int b, int& R, int& C) { const int st = b / 1024, sb = b % 1024, swz = sb ^ (((sb >> 9) & 1) << 5); R = (st >> 1) * 16 + swz / 64; C = (st & 1) * 32 + (swz % 64) / 2; }
__host__ __device__ __forceinline__ int perm32(int rho) { const int n = rho >> 4, i = rho & 15; return 8 * (i >> 2) + 4 * n + (i & 3); }

struct Unit { int type, pm, pn; };

struct Order {
    int nM, nN, nwg, G, c;
    __device__ void init(int nM_, int nN_, int G_, int c_) { nM = nM_; nN = nN_; nwg = nM * nN; G = G_; c = c_; }
    __device__ bool raw(int i, int& pm, int& pn) const {
        const long L = (long)i * G + c; if (L >= nwg) return false;
        int wgid = (int)L; { const int q = nwg / NXCD, r = nwg % NXCD, xcd = wgid % NXCD, off = wgid / NXCD; wgid = (xcd < r ? xcd * (q + 1) : r * (q + 1) + (xcd - r) * q) + off; }
        const int nig = WGM * nN, gid = wgid / nig, fm = gid * WGM, gsz = (nM - fm) < WGM ? (nM - fm) : WGM;
        pm = fm + ((wgid % nig) % gsz); pn = (wgid % nig) / gsz; return true;
    }
};

template <class Epi, class Sched>
__device__ __forceinline__ void gemm_phase(LAS unsigned char* lds, const int K, const Sched& S, const Epi& E) {
    const int tid = threadIdx.x, wid = __builtin_amdgcn_readfirstlane(tid >> 6), lane = tid & 63, wr = wid >> 2, wc = wid & 3, fr = lane & 15, fq = lane >> 4;
    const int nt = K / BK;
    unsigned voffA[2], vbR[2], vbC[2];
#pragma unroll
    for (int i = 0; i < 2; ++i) { int R, C; stage_rc(tid * 16 + i * 8192, R, C); const int Rb = Epi::PERM ? ((R & ~31) + perm32(R & 31)) : R;
        voffA[i] = (unsigned)(R * K + C) * 2u; vbR[i] = (unsigned)(Rb * K) * 2u; vbC[i] = (unsigned)C * 2u; }
    const size_t kstep = (size_t)(BK * 2);
    const size_t hstep = (size_t)HALF * K * 2;
    const unsigned ldsw = (unsigned)wid * 1024u;
    const int aoff = lds_byte(wr * 64 + fr, fq * 8), boff = lds_byte(wc * 32 + fr, fq * 8);
#define PG8_SA(b, h) (((b) * 2 + (h)) * HTB)
#define PG8_SB(b, h) ((4 + (b) * 2 + (h)) * HTB)
#define PG8_STAGE(bufoff, gbase, voff) do { _Pragma("unroll") for (int _i = 0; _i < 2; ++_i) \
        __builtin_amdgcn_global_load_lds((const unsigned*)((const char*)(gbase) + (voff)[_i]), (LAS unsigned*)(lds + (bufoff) + ldsw + _i * 8192), 16, 0, 0); } while (0)
#define PG8_LDA(dst, b, h) do { _Pragma("unroll") for (int m = 0; m < 4; ++m) _Pragma("unroll") for (int k = 0; k < 2; ++k) dst[m][k] = *(const LAS bf16x8*)(lds + PG8_SA(b, h) + aoff + m * 2048 + k * 1024); } while (0)
#define PG8_LDB(dst, b, h) do { _Pragma("unroll") for (int n = 0; n < 2; ++n) _Pragma("unroll") for (int k = 0; k < 2; ++k) dst[n][k] = *(const LAS bf16x8*)(lds + PG8_SB(b, h) + boff + n * 2048 + k * 1024); } while (0)
#define PG8_MMA(ai, bj, At, Bt) do { __builtin_amdgcn_s_setprio(1); _Pragma("unroll") for (int m = 0; m < 4; ++m) _Pragma("unroll") for (int n = 0; n < 2; ++n) _Pragma("unroll") for (int k = 0; k < 2; ++k) \
        acc[ai][bj][m][n] = __builtin_amdgcn_mfma_f32_16x16x32_bf16(Bt[n][k], At[m][k], acc[ai][bj][m][n], 0, 0, 0); __builtin_amdgcn_s_setprio(0); } while (0)
#define PG8_WAIT_V(n) asm volatile("s_waitcnt vmcnt(" #n ")" ::: "memory")
#define PG8_WAIT_L(n) asm volatile("s_waitcnt lgkmcnt(" #n ")" ::: "memory")
#define PG8_BAR __builtin_amdgcn_s_barrier()
#define PG8_SCHED __builtin_amdgcn_sched_barrier(0)
    Unit cur, nxt; int ui = 0;
    if (!S.next(0, cur)) return;
    f32x4 acc[2][2][4][2];
#pragma unroll
    for (int a = 0; a < 2; ++a)
#pragma unroll
        for (int b = 0; b < 2; ++b)
#pragma unroll
            for (int m = 0; m < 4; ++m)
#pragma unroll
                for (int n = 0; n < 2; ++n) acc[a][b][m][n] = (f32x4){0.f, 0.f, 0.f, 0.f};
    bf16x8 At[4][2], B0[2][2], B1[2][2];
    const char* cA; const char* cB; int cd;
    S.locate(cur, cA, cB, cd);
    size_t hstepB = hstep * (size_t)cd;
    {
    unsigned voffB[2] = {vbR[0] * (unsigned)cd + vbC[0], vbR[1] * (unsigned)cd + vbC[1]};
    PG8_STAGE(PG8_SB(0, 0), cB, voffB); PG8_STAGE(PG8_SB(0, 1), cB + hstepB, voffB); PG8_STAGE(PG8_SA(0, 0), cA, voffA); PG8_STAGE(PG8_SA(0, 1), cA + hstep, voffA);
    if (wr == 1) PG8_BAR;
    PG8_WAIT_V(2); PG8_BAR;
    PG8_STAGE(PG8_SB(1, 0), cB + kstep, voffB); PG8_STAGE(PG8_SA(1, 0), cA + kstep, voffA); PG8_STAGE(PG8_SB(1, 1), cB + hstepB + kstep, voffB);
    PG8_WAIT_V(6); PG8_BAR;
    }
    for (;;) {
        const bool has_next = S.next(ui + 1, nxt);
        const char* nA = cA; const char* nB = cB; int nd = cd;
        if (has_next) S.locate(nxt, nA, nB, nd);
        const size_t nhstepB = hstep * (size_t)nd;
        for (int t = 0; t < nt; t += 2) {
            const bool last = (t == nt - 2);
            if constexpr (Epi::HOOK_T >= 0) { if (t == Epi::HOOK_T) { int t2 = threadIdx.x; asm volatile("" : "+v"(t2)); E.hook(acc, cur, (t2 >> 8) & 1, (t2 >> 6) & 3, t2 & 15, (t2 >> 4) & 3); } }
            const char* a1 = cA + (size_t)(t + 1) * kstep;
            const char* a2 = last ? nA : cA + (size_t)(t + 2) * kstep; const char* b2 = last ? nB : cB + (size_t)(t + 2) * kstep;
            const char* a3 = a2 + kstep; const char* b3 = b2 + kstep;
            const unsigned dsel = (unsigned)(last ? nd : cd);
            unsigned vB2[2] = {vbR[0] * dsel + vbC[0], vbR[1] * dsel + vbC[1]};
            const size_t hB2 = last ? nhstepB : hstepB;
            PG8_LDB(B0, 0, 0); PG8_LDB(B1, 0, 1); PG8_SCHED; PG8_LDA(At, 0, 0); PG8_STAGE(PG8_SA(1, 1), a1 + hstep, voffA);
            PG8_WAIT_V(8); PG8_WAIT_L(0); PG8_BAR; PG8_MMA(0, 0, At, B0); PG8_MMA(0, 1, At, B1); PG8_BAR; PG8_SCHED;
            PG8_LDA(At, 0, 1); PG8_STAGE(PG8_SB(0, 0), b2, vB2); PG8_STAGE(PG8_SB(0, 1), b2 + hB2, vB2); PG8_STAGE(PG8_SA(0, 0), a2, voffA);
            PG8_WAIT_V(8); PG8_WAIT_L(0); PG8_BAR; PG8_MMA(1, 0, At, B0); PG8_MMA(1, 1, At, B1); PG8_BAR; PG8_SCHED;
            PG8_LDB(B0, 1, 0); PG8_LDB(B1, 1, 1); PG8_SCHED; PG8_LDA(At, 1, 0); PG8_STAGE(PG8_SA(0, 1), a2 + hstep, voffA);
            PG8_WAIT_V(8); PG8_WAIT_L(0); PG8_BAR; PG8_MMA(0, 0, At, B0); PG8_MMA(0, 1, At, B1); PG8_BAR; PG8_SCHED;
            PG8_LDA(At, 1, 1); PG8_STAGE(PG8_SB(1, 0), b3, vB2); PG8_STAGE(PG8_SB(1, 1), b3 + hB2, vB2); PG8_STAGE(PG8_SA(1, 0), a3, voffA);
            PG8_WAIT_V(8); PG8_WAIT_L(0); PG8_BAR; PG8_MMA(1, 0, At, B0); PG8_MMA(1, 1, At, B1); PG8_BAR; PG8_SCHED;
        }
        if (wr == 0) PG8_BAR;
        { int t2 = threadIdx.x; asm volatile("" : "+v"(t2)); E(acc, cur, (t2 >> 8) & 1, (t2 >> 6) & 3, t2 & 15, (t2 >> 4) & 3); }
        if (!has_next) break;
#pragma unroll
        for (int a = 0; a < 2; ++a)
#pragma unroll
            for (int b = 0; b < 2; ++b)
#pragma unroll
                for (int m = 0; m < 4; ++m)
#pragma unroll
                    for (int n = 0; n < 2; ++n) acc[a][b][m][n] = (f32x4){0.f, 0.f, 0.f, 0.f};
        cur = nxt; cA = nA; cB = nB; cd = nd; hstepB = nhstepB; ++ui;
        if (wr == 1) PG8_BAR;
    }
    PG8_WAIT_V(0);
    PG8_BAR;
#undef PG8_SA
#undef PG8_SB
#undef PG8_STAGE
#undef PG8_LDA
#undef PG8_LDB
#undef PG8_MMA
#undef PG8_WAIT_V
#undef PG8_WAIT_L
#undef PG8_BAR
#undef PG8_SCHED
}
}
using pg8::Unit;

__device__ __forceinline__ u32x4 pack8(const f32x4 a, const f32x4 b) { u32x4 w; w.x = cvt_pk(a[0], a[1]); w.y = cvt_pk(a[2], a[3]); w.z = cvt_pk(b[0], b[1]); w.w = cvt_pk(b[2], b[3]); return w; }

struct SchedIn {
    pg8::Order o; int part; const char* XB; const char* WIN;
    __device__ __forceinline__ bool next(int i, Unit& u) const {
        int pm, vn; if (!o.raw(i, pm, vn)) return false;
        if (part == 0) {
            if (vn < 12) { u.type = 0; u.pm = pm; u.pn = vn; }
            else if (vn < 26) { u.type = 0; u.pm = pm; u.pn = vn + 8; }
            else { u.type = 1; u.pm = vn - 26; u.pn = pm; }
        } else {
            u.type = 0; u.pm = pm; u.pn = vn < 2 ? 34 + vn : (vn < 4 ? 16 + vn : 32 + vn);
        }
        return true;
    }
    __device__ __forceinline__ void locate(const Unit& u, const char*& A, const char*& B, int& dB) const {
        if (u.type == 0) { A = XB + (size_t)u.pm * 256 * D * 2; B = WIN + (size_t)u.pn * 256 * D * 2; dB = 1; }
        else { const int g = u.pm >> 1, dsh = 2 * g, b0 = u.pn * 256, r = b0 >> (14 - dsh), l0 = b0 & ((16384 >> dsh) - 1);
               A = WIN + (size_t)(12 + u.pm) * 256 * D * 2; B = XB + (size_t)((l0 << dsh) + r) * D * 2; dB = 1 << dsh; }
    }
};
struct EpiIn {
    static constexpr bool PERM = true; static constexpr int HOOK_T = -1;
    bf16_t *QK, *VT, *SG, *U, *P, *RATIO, *GA; const float* b_gate;
    __device__ __forceinline__ void hook(f32x4 (&)[2][2][4][2], const Unit&, int, int, int, int) const {}
    __device__ __forceinline__ void operator()(const f32x4 (&acc)[2][2][4][2], const Unit& u, int wr, int wc, int fr, int fq) const {
        const int cl = wc * 32 + 8 * fq;
        if (u.type == 1) {
            bf16_t* base = VT + (size_t)(u.pm * 256 + wr * 64 + fr) * S + u.pn * 256 + cl;
#pragma unroll
            for (int ai = 0; ai < 2; ++ai)
#pragma unroll
                for (int m = 0; m < 4; ++m) { bf16_t* rowp = base + (size_t)(ai * 128 + m * 16) * S;
#pragma unroll
                    for (int bj = 0; bj < 2; ++bj) *(u32x4*)(rowp + bj * 128) = pack8(acc[ai][bj][m][0], acc[ai][bj][m][1]); }
            return;
        }
        const int row0 = u.pm * 256 + wr * 64 + fr, wt = u.pn;
        if (wt < 12) {
            const float sc = wt < 6 ? C2 : 1.0f;
            bf16_t* base = QK + (size_t)row0 * 3072 + wt * 256 + cl;
#pragma unroll
            for (int ai = 0; ai < 2; ++ai)
#pragma unroll
                for (int m = 0; m < 4; ++m) { bf16_t* rowp = base + (size_t)(ai * 128 + m * 16) * 3072;
#pragma unroll
                    for (int bj = 0; bj < 2; ++bj) *(u32x4*)(rowp + bj * 128) = pack8(acc[ai][bj][m][0] * sc, acc[ai][bj][m][1] * sc); }
        } else if (wt < 20) {
            bf16_t* base = SG + (size_t)row0 * AW + (wt - 18) * 256 + cl;
#pragma unroll
            for (int ai = 0; ai < 2; ++ai)
#pragma unroll
                for (int m = 0; m < 4; ++m) { bf16_t* rowp = base + (size_t)(ai * 128 + m * 16) * AW;
#pragma unroll
                    for (int bj = 0; bj < 2; ++bj) { f32x4 v0 = acc[ai][bj][m][0], v1 = acc[ai][bj][m][1];
#pragma unroll
                        for (int j = 0; j < 4; ++j) { v0[j] = siluf_(v0[j]); v1[j] = siluf_(v1[j]); }
                        *(u32x4*)(rowp + bj * 128) = pack8(v0, v1); } }
        } else if (wt < 36) {
            const bool isU = wt < 28;
            bf16_t* base = (isU ? U + (size_t)(wt - 20) * 128 : P + (size_t)(wt - 28) * 128) + (size_t)row0 * D + cl;
#pragma unroll
            for (int ai = 0; ai < 2; ++ai)
#pragma unroll
                for (int m = 0; m < 4; ++m) { bf16_t* rowp = base + (size_t)(ai * 128 + m * 16) * D;
                    f32x4 v0 = acc[ai][1][m][0], v1 = acc[ai][1][m][1];
                    if (!isU) {
#pragma unroll
                        for (int j = 0; j < 4; ++j) { v0[j] = siluf_(v0[j]); v1[j] = siluf_(v1[j]); } }
                    v0 = v0 * acc[ai][0][m][0]; v1 = v1 * acc[ai][0][m][1];
                    *(u32x4*)rowp = pack8(v0, v1); }
        } else {
            const int ch = (wt - 36) * 128 + cl;
            const f32x4 bc0 = *(const f32x4*)(b_gate + ch), bc1 = *(const f32x4*)(b_gate + ch + 4), ba0 = *(const f32x4*)(b_gate + D + ch), ba1 = *(const f32x4*)(b_gate + D + ch + 4);
#pragma unroll
            for (int ai = 0; ai < 2; ++ai)
#pragma unroll
                for (int m = 0; m < 4; ++m) { const size_t off = (size_t)(row0 + ai * 128 + m * 16) * D + ch;
                    f32x4 c0 = acc[ai][0][m][0] + bc0, c1 = acc[ai][0][m][1] + bc1, a0 = acc[ai][1][m][0] + ba0, a1 = acc[ai][1][m][1] + ba1;
                    f32x4 r0, r1, g0, g1;
#pragma unroll
                    for (int j = 0; j < 4; ++j) { const float ea0 = 1.0f + __expf(-a0[j]), ea1 = 1.0f + __expf(-a1[j]);
                        g0[j] = __builtin_amdgcn_rcpf(ea0); g1[j] = __builtin_amdgcn_rcpf(ea1);
                        r0[j] = ea0 * sigmoidf_(c0[j]); r1[j] = ea1 * sigmoidf_(c1[j]); }
                    *(u32x4*)(RATIO + off) = pack8(r0, r1); *(u32x4*)(GA + off) = pack8(g0, g1); }
        }
    }
};

struct SchedPlain {
    pg8::Order o; const char* A; const char* Bt; int K;
    __device__ __forceinline__ bool next(int i, Unit& u) const { u.type = 0; return o.raw(i, u.pm, u.pn); }
    __device__ __forceinline__ void locate(const Unit& u, const char*& a, const char*& b, int& dB) const { a = A + (size_t)u.pm * 256 * K * 2; b = Bt + (size_t)u.pn * 256 * K * 2; dB = 1; }
};
struct EpiY {
    static constexpr bool PERM = true; static constexpr int HOOK_T = 16;
    const bf16_t *RATIO, *GA; bf16_t* MERGED;
    __device__ __forceinline__ void hook(f32x4 (&acc)[2][2][4][2], const Unit& u, int wr, int wc, int fr, int fq) const {
        const bf16_t* base = RATIO + (size_t)(u.pm * 256 + wr * 64 + fr) * D + u.pn * 256 + wc * 32 + 8 * fq;
#pragma unroll
        for (int ai = 0; ai < 2; ++ai) {
#pragma unroll
            for (int m = 0; m < 4; ++m)
#pragma unroll
                for (int bj = 0; bj < 2; ++bj) { const u32x4 w = *(const u32x4*)(base + (size_t)(ai * 128 + m * 16) * D + bj * 128);
                    acc[ai][bj][m][0] = acc[ai][bj][m][0] * (f32x4){bf_lo(w.x), bf_hi(w.x), bf_lo(w.y), bf_hi(w.y)};
                    acc[ai][bj][m][1] = acc[ai][bj][m][1] * (f32x4){bf_lo(w.z), bf_hi(w.z), bf_lo(w.w), bf_hi(w.w)}; }
            asm volatile("" ::: "memory");
        }
    }
    __device__ __forceinline__ void operator()(const f32x4 (&acc)[2][2][4][2], const Unit& u, int wr, int wc, int fr, int fq) const {
        const size_t off0 = (size_t)(u.pm * 256 + wr * 64 + fr) * D + u.pn * 256 + wc * 32 + 8 * fq;
#pragma unroll
        for (int ai = 0; ai < 2; ++ai) {
#pragma unroll
            for (int m = 0; m < 4; ++m)
#pragma unroll
                for (int bj = 0; bj < 2; ++bj) { const size_t off = off0 + (size_t)(ai * 128 + m * 16) * D + bj * 128; const u32x4 w = *(const u32x4*)(GA + off);
                    const f32x4 v0 = acc[ai][bj][m][0] * (f32x4){bf_lo(w.x), bf_hi(w.x), bf_lo(w.y), bf_hi(w.y)};
                    const f32x4 v1 = acc[ai][bj][m][1] * (f32x4){bf_lo(w.z), bf_hi(w.z), bf_lo(w.w), bf_hi(w.w)};
                    *(u32x4*)(MERGED + off) = pack8(v0, v1); }
            asm volatile("" ::: "memory");
        }
    }
};
struct EpiO {
    static constexpr bool PERM = false; static constexpr int HOOK_T = -1;
    const float* x; float* out;
    __device__ __forceinline__ void hook(f32x4 (&)[2][2][4][2], const Unit&, int, int, int, int) const {}
    __device__ __forceinline__ void operator()(const f32x4 (&acc)[2][2][4][2], const Unit& u, int wr, int wc, int fr, int fq) const {
        const size_t off0 = (size_t)(u.pm * 256 + wr * 64 + fr) * D + u.pn * 256 + wc * 32 + 4 * fq;
#pragma unroll
        for (int ai = 0; ai < 2; ++ai)
#pragma unroll
            for (int m = 0; m < 4; ++m)
#pragma unroll
                for (int bj = 0; bj < 2; ++bj)
#pragma unroll
                    for (int n = 0; n < 2; ++n) { const size_t off = off0 + (size_t)(ai * 128 + m * 16) * D + bj * 128 + n * 16;
                        const f32x4 xv = *(const f32x4*)(x + off); *(f32x4*)(out + off) = xv * DN_ALPHA + acc[ai][bj][m][n]; }
    }
};

__device__ __forceinline__ unsigned f2bf(float f) { unsigned u = __builtin_bit_cast(unsigned, f); return (u + 0x7fffu + ((u >> 16) & 1u)) >> 16; }
__device__ __forceinline__ unsigned pk2(float lo, float hi) { return f2bf(lo) | (f2bf(hi) << 16); }
__device__ __forceinline__ void p0_transpose_item(const float* W, int N, bf16_t* WT, int ldk, int koff, int drow, int k0, int n0, LAS float* scr, int lane) {
#pragma unroll 8
    for (int i = 0; i < 32; ++i) { const int kk = 2 * i + (lane >> 5); scr[kk * 33 + (lane & 31)] = W[(size_t)(k0 + kk) * N + n0 + (lane & 31)]; }
    asm volatile("s_waitcnt lgkmcnt(0)" ::: "memory");
    const int c = lane & 7;
#pragma unroll
    for (int j = 0; j < 4; ++j) { const int n = (lane >> 3) + 8 * j; const LAS float* s = scr + (8 * c) * 33 + n;
        u32x4 o; o.x = pk2(s[0 * 33], s[1 * 33]); o.y = pk2(s[2 * 33], s[3 * 33]); o.z = pk2(s[4 * 33], s[5 * 33]); o.w = pk2(s[6 * 33], s[7 * 33]);
        *(u32x4*)(WT + (size_t)(drow + n) * ldk + koff + k0 + 8 * c) = o; }
    asm volatile("s_waitcnt lgkmcnt(0)" ::: "memory");
}
__device__ __forceinline__ int drow_win(int n) {
    if (n < 5120) return n;
    const int sec = (n - 5120) >> 10, c = (n - 5120) & 1023;
    const int base = (sec == 0 || sec == 2) ? 5120 : ((sec == 1 || sec == 3) ? 7168 : 9216);
    const int half = (sec == 2 || sec == 3 || sec == 5) ? 1 : 0;
    return base + (c >> 7) * 256 + half * 128 + (c & 127);
}

__device__ __forceinline__ void attn_unit(int u, const bf16_t* __restrict__ QK, const bf16_t* __restrict__ VT, bf16_t* __restrict__ OG, float* __restrict__ LSE, int wid, int lane) {
    const int g = u >> 9, rem = u & 511, h = rem >> 6, blk = rem & 63;
    const int dsh = 2 * g, L = 16384 >> dsh;
    const int b0 = blk * 256, r = b0 >> (14 - dsh), l0 = b0 & (L - 1);
    const int lq0 = l0 + 32 * wid;
    const int q = lane & 31, hh = lane >> 5;
    const int colq = g * 512 + h * 64;
    const bf16_t* qp = QK + (size_t)(((lq0 + q) << dsh) + r) * 3072 + colq + 8 * hh;
    bf16x8 qf[4];
#pragma unroll
    for (int ks = 0; ks < 4; ++ks) qf[ks] = *(const bf16x8*)(qp + 16 * ks);
    const int pi = (q & 19) | ((q & 4) << 1) | ((q & 8) >> 1);
    const bool first = (l0 == 0);
    f32x16 s[5];
#pragma unroll
    for (int c = 0; c < 5; ++c) {
        const bool valid = !(first && (wid + c < 4));
        if (valid) {
            const int kl = lq0 - 128 + 32 * c + pi;
            const bf16_t* kp = QK + (size_t)((kl << dsh) + r) * 3072 + QKVW + colq + 8 * hh;
            f32x16 a = {0.f, 0.f, 0.f, 0.f, 0.f, 0.f, 0.f, 0.f, 0.f, 0.f, 0.f, 0.f, 0.f, 0.f, 0.f, 0.f};
#pragma unroll
            for (int ks = 0; ks < 4; ++ks) { const bf16x8 kf = *(const bf16x8*)(kp + 16 * ks); a = __builtin_amdgcn_mfma_f32_32x32x16_bf16(kf, qf[ks], a, 0, 0, 0); }
            s[c] = a;
        } else {
#pragma unroll
            for (int i = 0; i < 16; ++i) s[c][i] = -INFINITY;
        }
    }
#pragma unroll
    for (int i = 0; i < 16; ++i) { const int ko = 16 * (i >> 3) + 8 * hh + (i & 7); if (ko < q) s[0][i] = -INFINITY; if (ko > q) s[4][i] = -INFINITY; }
    float m = -INFINITY;
#pragma unroll
    for (int c = 0; c < 5; ++c)
#pragma unroll
        for (int i = 0; i < 16; ++i) m = fmaxf(m, s[c][i]);
    m = fmaxf(m, __shfl_xor(m, 32));
    float l = 0.f;
#pragma unroll
    for (int c = 0; c < 5; ++c)
#pragma unroll
        for (int i = 0; i < 16; ++i) { const float p = __builtin_amdgcn_exp2f(s[c][i] - m); s[c][i] = p; l += p; }
    l += __shfl_xor(l, 32);
    f32x16 o[2];
#pragma unroll
    for (int e = 0; e < 2; ++e)
#pragma unroll
        for (int i = 0; i < 16; ++i) o[e][i] = 0.f;
    const bf16_t* vp = VT + (size_t)(colq + q) * S + (size_t)r * L + lq0 - 128 + 8 * hh;
#pragma unroll
    for (int c = 0; c < 5; ++c) {
        const bool valid = !(first && (wid + c < 4));
        if (valid) {
#pragma unroll
            for (int st = 0; st < 2; ++st) {
                u32x4 pw; pw.x = cvt_pk(s[c][8 * st + 0], s[c][8 * st + 1]); pw.y = cvt_pk(s[c][8 * st + 2], s[c][8 * st + 3]); pw.z = cvt_pk(s[c][8 * st + 4], s[c][8 * st + 5]); pw.w = cvt_pk(s[c][8 * st + 6], s[c][8 * st + 7]);
                const bf16x8 pf = __builtin_bit_cast(bf16x8, pw);
#pragma unroll
                for (int e = 0; e < 2; ++e) { const bf16x8 vf = *(const bf16x8*)(vp + (size_t)(32 * e) * S + 32 * c + 16 * st);
                    o[e] = __builtin_amdgcn_mfma_f32_32x32x16_bf16(vf, pf, o[e], 0, 0, 0); }
            }
        }
    }
    const float inv = 1.0f / l, lse2 = m + __builtin_amdgcn_logf(l);
    const int token = ((lq0 + q) << dsh) + r;
    bf16_t* op = OG + ((size_t)g * S + token) * AW + h * 64 + 4 * hh;
#pragma unroll
    for (int e = 0; e < 2; ++e)
#pragma unroll
        for (int a = 0; a < 4; ++a) { u32x2 w; w.x = cvt_pk(o[e][4 * a] * inv, o[e][4 * a + 1] * inv); w.y = cvt_pk(o[e][4 * a + 2] * inv, o[e][4 * a + 3] * inv);
            *(u32x2*)(op + 32 * e + 8 * a) = w; }
    if (hh == 0) LSE[((size_t)g * S + token) * 8 + h] = lse2;
}

constexpr int RING_BYTES = 131072, LDS_BYTES = 147456;
struct Args { const float* in[9]; float* out; unsigned char* ws; int lo, hi; };

__device__ __forceinline__ float wave_sum(float v) {
#pragma unroll
    for (int o = 1; o < 64; o <<= 1) v += __shfl_xor(v, o);
    return v;
}

__global__ void __launch_bounds__(512, 2) fwd(Args a) {
    extern __shared__ __attribute__((aligned(16))) unsigned char lds_raw[];
    LAS unsigned char* lds = (LAS unsigned char*)lds_raw;
    const int tid = threadIdx.x, lane = tid & 63, wave = __builtin_amdgcn_readfirstlane(tid >> 6);
    const int G = gridDim.x, bx = blockIdx.x;
    const int vcu = (G % 8 == 0) ? (bx % 8) * (G / 8) + bx / 8 : bx;
    const int gw = vcu * 8 + wave, NGW = G * 8;
#define PTRS() \
    const float* x = a.in[0]; const float* w_in = a.in[1]; const float* conv_w = a.in[2]; const float* w_co = a.in[3]; const float* w_ao = a.in[4]; \
    const float* b_gate = a.in[5]; const float* w_o = a.in[6]; const float* ln_g = a.in[7]; const float* ln_b = a.in[8]; \
    unsigned char* ws = a.ws; float* out = a.out; \
    bf16_t* XB = (bf16_t*)(ws + WS_XB); bf16_t* WIN = (bf16_t*)(ws + WS_WIN); bf16_t* WY = (bf16_t*)(ws + WS_WY); bf16_t* WO = (bf16_t*)(ws + WS_WO); \
    bf16_t* QK = (bf16_t*)(ws + WS_QK); bf16_t* VT = (bf16_t*)(ws + WS_VT); bf16_t* OG = (bf16_t*)(ws + WS_OG); float* LSE = (float*)(ws + WS_LSE); \
    bf16_t* SG = (bf16_t*)(ws + WS_SG); bf16_t* RATIO = (bf16_t*)(ws + WS_RATIO); bf16_t* GA = (bf16_t*)(ws + WS_GA); bf16_t* A2 = (bf16_t*)(ws + WS_A2); \
    bf16_t* MERGED = (bf16_t*)(ws + WS_MERGED); \
    bf16_t* U = (bf16_t*)out; bf16_t* P = (bf16_t*)out + (size_t)S * D; \
    (void)x; (void)w_in; (void)conv_w; (void)w_co; (void)w_ao; (void)b_gate; (void)w_o; (void)ln_g; (void)ln_b; (void)XB; (void)WIN; (void)WY; (void)WO; (void)QK; (void)VT; (void)OG; (void)LSE; \
    (void)SG; (void)RATIO; (void)GA; (void)A2; (void)MERGED; (void)U; (void)P;
    const int lo = a.lo, hi = a.hi;
#define IN(k) (lo <= (k) && (k) < hi)
#define SEAM(k) do { if (IN(k) && IN((k) + 1)) { cg::this_grid().sync(); } } while (0)

    if (IN(0)) {
        PTRS();
        for (size_t i = (size_t)bx * 512 + tid; i < (size_t)S * D / 8; i += (size_t)G * 512) {
            const f32x4 v0 = *(const f32x4*)(x + i * 8), v1 = *(const f32x4*)(x + i * 8 + 4);
            *(u32x4*)(XB + i * 8) = pack8(v0, v1);
        }
        LAS float* scr = (LAS float*)(lds + wave * 16384);
        constexpr int I_IN = 16 * (NIN / 32), I_CO = 16 * 32, I_AO = 8 * 32, I_O = 16 * 32, NITEMS = I_IN + I_CO + I_AO + I_O;
        for (int it = gw; it < NITEMS; it += NGW) {
            int r = it;
            if (r < I_IN) { const int kb = r / (NIN / 32), nb = r % (NIN / 32); p0_transpose_item(w_in, NIN, WIN, D, 0, drow_win(nb * 32), kb * 64, nb * 32, scr, lane); continue; } r -= I_IN;
            if (r < I_CO) { const int kb = r / 32, nb = r % 32; p0_transpose_item(w_co, D, WY, 1536, 0, nb * 32, kb * 64, nb * 32, scr, lane); continue; } r -= I_CO;
            if (r < I_AO) { const int kb = r / 32, nb = r % 32; p0_transpose_item(w_ao, D, WY, 1536, 1024, nb * 32, kb * 64, nb * 32, scr, lane); continue; } r -= I_AO;
            { const int kb = r / 32, nb = r % 32; p0_transpose_item(w_o, D, WO, D, 0, nb * 32, kb * 64, nb * 32, scr, lane); }
        }
        __syncthreads();
    }
    SEAM(0);

    if (IN(1)) {
        PTRS();
        SchedIn Sc; Sc.o.init(64, 32, G, bx); Sc.part = 0; Sc.XB = (const char*)XB; Sc.WIN = (const char*)WIN;
        EpiIn E{QK, VT, SG, U, P, RATIO, GA, b_gate};
        pg8::gemm_phase<EpiIn, SchedIn>(lds, D, Sc, E);
    }
    SEAM(1);

    if (IN(2)) {
        PTRS();
        for (int u = vcu; u < 1536; u += G) attn_unit(u, QK, VT, OG, LSE, wave, lane);
    }
    SEAM(2);

    if (IN(3)) {
        PTRS();
        SchedIn Sc; Sc.o.init(64, 12, G, bx); Sc.part = 1; Sc.XB = (const char*)XB; Sc.WIN = (const char*)WIN;
        EpiIn E{QK, VT, SG, U, P, RATIO, GA, b_gate};
        pg8::gemm_phase<EpiIn, SchedIn>(lds, D, Sc, E);
    }
    SEAM(3);

    if (IN(4)) {
        PTRS();
        for (size_t idx = (size_t)bx * 512 + tid; idx < (size_t)S * 192; idx += (size_t)G * 512) {
            const int t = (int)(idx / 192), c8 = (int)(idx % 192);
            if (c8 < 128) {
                const int ch = c8 * 8;
                const u32x4 pw = *(const u32x4*)(P + (size_t)t * D + ch);
                const u32x4 u0 = *(const u32x4*)(U + (size_t)t * D + ch);
                u32x4 u1 = {0u, 0u, 0u, 0u}, u2 = {0u, 0u, 0u, 0u};
                if (t >= 1) u1 = *(const u32x4*)(U + (size_t)(t - 1) * D + ch);
                if (t >= 2) u2 = *(const u32x4*)(U + (size_t)(t - 2) * D + ch);
                float r[8];
#pragma unroll
                for (int j = 0; j < 4; ++j) {
                    const unsigned wp = pw[j], w0 = u0[j], w1 = u1[j], w2 = u2[j];
                    const int c0 = ch + 2 * j, c1 = c0 + 1;
                    r[2 * j] = bf_lo(wp) * (conv_w[c0] * bf_lo(w2) + conv_w[D + c0] * bf_lo(w1) + conv_w[2 * D + c0] * bf_lo(w0));
                    r[2 * j + 1] = bf_hi(wp) * (conv_w[c1] * bf_hi(w2) + conv_w[D + c1] * bf_hi(w1) + conv_w[2 * D + c1] * bf_hi(w0));
                }
                u32x4 ov; ov.x = cvt_pk(r[0], r[1]); ov.y = cvt_pk(r[2], r[3]); ov.z = cvt_pk(r[4], r[5]); ov.w = cvt_pk(r[6], r[7]);
                *(u32x4*)(A2 + (size_t)t * 1536 + ch) = ov;
            } else {
                const int col = (c8 - 128) * 8, h = col >> 6;
                const float l0 = LSE[((size_t)0 * S + t) * 8 + h], l1 = LSE[((size_t)1 * S + t) * 8 + h], l2 = LSE[((size_t)2 * S + t) * 8 + h];
                const float mx = fmaxf(l0, fmaxf(l1, l2));
                float e0 = __builtin_amdgcn_exp2f(l0 - mx), e1 = __builtin_amdgcn_exp2f(l1 - mx), e2 = __builtin_amdgcn_exp2f(l2 - mx);
                const float inv = 1.0f / (e0 + e1 + e2); e0 *= inv; e1 *= inv; e2 *= inv;
                const u32x4 o0 = *(const u32x4*)(OG + ((size_t)0 * S + t) * AW + col), o1 = *(const u32x4*)(OG + ((size_t)1 * S + t) * AW + col), o2 = *(const u32x4*)(OG + ((size_t)2 * S + t) * AW + col);
                const u32x4 sg = *(const u32x4*)(SG + (size_t)t * AW + col);
                float r[8];
#pragma unroll
                for (int j = 0; j < 4; ++j) {
                    r[2 * j] = bf_lo(sg[j]) * (e0 * bf_lo(o0[j]) + e1 * bf_lo(o1[j]) + e2 * bf_lo(o2[j]));
                    r[2 * j + 1] = bf_hi(sg[j]) * (e0 * bf_hi(o0[j]) + e1 * bf_hi(o1[j]) + e2 * bf_hi(o2[j]));
                }
                u32x4 ov; ov.x = cvt_pk(r[0], r[1]); ov.y = cvt_pk(r[2], r[3]); ov.z = cvt_pk(r[4], r[5]); ov.w = cvt_pk(r[6], r[7]);
                *(u32x4*)(A2 + (size_t)t * 1536 + 1024 + col) = ov;
            }
        }
    }
    SEAM(4);

    if (IN(5)) {
        PTRS();
        SchedPlain Sc; Sc.o.init(64, 4, G, bx); Sc.A = (const char*)A2; Sc.Bt = (const char*)WY; Sc.K = 1536;
        EpiY E{RATIO, GA, MERGED};
        pg8::gemm_phase<EpiY, SchedPlain>(lds, 1536, Sc, E);
    }
    SEAM(5);

    if (IN(6)) {
        PTRS();
        SchedPlain Sc; Sc.o.init(64, 4, G, bx); Sc.A = (const char*)MERGED; Sc.Bt = (const char*)WO; Sc.K = D;
        EpiO E{x, out};
        pg8::gemm_phase<EpiO, SchedPlain>(lds, D, Sc, E);
    }
    SEAM(6);

    if (IN(7)) {
        PTRS();
        f32x4 gv[4], bv[4];
#pragma unroll
        for (int j = 0; j < 4; ++j) { gv[j] = *((const f32x4*)ln_g + lane + 64 * j); bv[j] = *((const f32x4*)ln_b + lane + 64 * j); }
        for (int mrow = gw; mrow < S; mrow += NGW) {
            f32x4* xr = (f32x4*)(out + (size_t)mrow * D) + lane;
            f32x4 v[4]; float s = 0.f;
#pragma unroll
            for (int j = 0; j < 4; ++j) { v[j] = xr[64 * j]; s += (v[j].x + v[j].y) + (v[j].z + v[j].w); }
            const float mean = wave_sum(s) * (1.f / D); float s2 = 0.f;
#pragma unroll
            for (int j = 0; j < 4; ++j) { v[j] = v[j] - mean; s2 += (v[j].x * v[j].x + v[j].y * v[j].y) + (v[j].z * v[j].z + v[j].w * v[j].w); }
            const float rstd = 1.f / sqrtf(wave_sum(s2) * (1.f / D) + LN_EPS);
#pragma unroll
            for (int j = 0; j < 4; ++j) xr[64 * j] = v[j] * rstd * gv[j] + bv[j];
        }
    }
#undef IN
#undef SEAM
}

extern "C" void kernel_launch(void* const* d_in, const int* in_sizes, int n_in, void* d_out, int out_size, void* d_ws, size_t ws_size, hipStream_t stream) {
    static int grid = 0;
    if (grid == 0) {
        if (n_in != 9 || in_sizes[0] != S * D || in_sizes[1] != D * NIN || out_size != S * D || ws_size < WS_END) {
            fprintf(stderr, "kernel_launch: unexpected shapes (n_in %d, in0 %d, in1 %d, out %d, ws %zu)\n", n_in, n_in > 0 ? in_sizes[0] : -1, n_in > 1 ? in_sizes[1] : -1, out_size, ws_size); grid = -1; return; }
        int dev = 0, cus = 0, per_cu = 0;
        hipGetDevice(&dev); hipDeviceGetAttribute(&cus, hipDeviceAttributeMultiprocessorCount, dev);
        hipFuncSetAttribute((const void*)fwd, hipFuncAttributeMaxDynamicSharedMemorySize, LDS_BYTES);
        hipOccupancyMaxActiveBlocksPerMultiprocessor(&per_cu, (const void*)fwd, 512, LDS_BYTES);
        if (per_cu < 1) { fprintf(stderr, "kernel_launch: occupancy query says %d blocks/CU\n", per_cu); per_cu = 1; }
        (void)hipGetLastError();
        grid = cus;
    }
    if (grid < 0) return;
    Args a{};
    for (int i = 0; i < 9; ++i) a.in[i] = (const float*)d_in[i];
    a.out = (float*)d_out; a.ws = (unsigned char*)d_ws;
#if N_LAUNCH_MODE == 1
    a.lo = 0; a.hi = NPH;
    void* args[] = {&a};
    hipError_t e = hipLaunchCooperativeKernel((const void*)fwd, dim3(grid), dim3(512), args, LDS_BYTES, stream);
    if (e != hipSuccess) fprintf(stderr, "cooperative launch failed: %s (grid %d)\n", hipGetErrorString(e), grid);
#else
    for (int p = 0; p < NPH; ++p) { a.lo = p; a.hi = p + 1; hipLaunchKernelGGL(fwd, dim3(grid), dim3(512), LDS_BYTES, stream, a); }
#endif
}
```

```cpp
#include <hip/hip_runtime.h>
#include <hip/hip_cooperative_groups.h>
#include <cstdio>
#include <cstdint>
namespace cg = cooperative_groups;

#ifndef N_LAUNCH_MODE
#define N_LAUNCH_MODE 1
#endif

#ifndef DUP_PHASE
#define DUP_PHASE -1
#endif
#define LAS __attribute__((address_space(3)))
#define GAS __attribute__((address_space(1)))
typedef unsigned short bf16_t;
typedef short bf16x8 __attribute__((ext_vector_type(8)));
typedef float f32x4 __attribute__((ext_vector_type(4)));
typedef float f32x2 __attribute__((ext_vector_type(2)));
typedef float f32x16 __attribute__((ext_vector_type(16)));
typedef unsigned u32x4 __attribute__((ext_vector_type(4)));
typedef unsigned u32x2 __attribute__((ext_vector_type(2)));
typedef __bf16 bf16x2_t __attribute__((ext_vector_type(2)));

constexpr int S = 16384, D = 1024, NIN = 11264, QKVW = 1536, AW = 512;
constexpr float LN_EPS = 1e-5f;
constexpr float DN_ALPHA = 1.189207115002721f;
constexpr float C2 = 0.125f * 1.4426950408889634f;
constexpr int NPH = 8;

constexpr size_t MiB = 1u << 20;
constexpr size_t WS_XB = 0;
constexpr size_t WS_WIN = 32 * MiB;
constexpr size_t WS_WY = 54 * MiB;
constexpr size_t WS_WO = 57 * MiB;
constexpr size_t WS_QK = 59 * MiB;
constexpr size_t WS_VT = 155 * MiB;
constexpr size_t WS_OG = 203 * MiB;
constexpr size_t WS_LSE = 251 * MiB;
constexpr size_t WS_CTL = 253 * MiB, CTL_BYTES = 16384;
constexpr size_t WS_END = 254 * MiB;
constexpr size_t WS_SG = WS_QK, WS_RATIO = WS_QK + 16 * MiB, WS_GA = WS_QK + 48 * MiB, WS_A2 = WS_VT, WS_MERGED = WS_XB;

__device__ __forceinline__ unsigned cvt_pk(float lo, float hi) { f32x2 v = {lo, hi}; bf16x2_t b = __builtin_convertvector(v, bf16x2_t); return __builtin_bit_cast(unsigned, b); }
__device__ __forceinline__ float bf_lo(unsigned w) { return __uint_as_float(w << 16); }
__device__ __forceinline__ float bf_hi(unsigned w) { return __uint_as_float(w & 0xffff0000u); }
__device__ __forceinline__ float sigmoidf_(float x) { return __builtin_amdgcn_rcpf(1.0f + __expf(-x)); }
__device__ __forceinline__ float siluf_(float x) { return x * sigmoidf_(x); }

namespace pg8 {
constexpr int BM = 256, BK = 64, HALF = 128, HTB = HALF * BK * 2, STAGE_BYTES = 8 * HTB, NXCD = 8, WGM = 8;
__host__ __device__ __forceinline__ int lds_byte(int r, int c) { const int st = (r >> 4) * 2 + (c >> 5), rr = r & 15, cc = c & 31, ob = rr * 64 + cc * 2; return st * 1024 + (ob ^ (((ob >> 9) & 1) << 5)); }
__host__ __device__ __forceinline__ void stage_rc(int b, int& R, int& C) { const int st = b / 1024, sb = b % 1024, swz = sb ^ (((sb >> 9) & 1) << 5); R = (st >> 1) * 16 + swz / 64; C = (st & 1) * 32 + (swz % 64) / 2; }
__host__ __device__ __forceinline__ int perm32(int rho) { const int n = rho >> 4, i = rho & 15; return 8 * (i >> 2) + 4 * n + (i & 3); }

struct Unit { int type, pm, pn; };

struct Order {
    int nM, nN, nwg, G, c;
    __device__ void init(int nM_, int nN_, int G_, int c_) { nM = nM_; nN = nN_; nwg = nM * nN; G = G_; c = c_; }
    __device__ bool raw(int i, int& pm, int& pn) const {
        const long L = (long)i * G + c; if (L >= nwg) return false;
        int wgid = (int)L; { const int q = nwg / NXCD, r = nwg % NXCD, xcd = wgid % NXCD, off = wgid / NXCD; wgid = (xcd < r ? xcd * (q + 1) : r * (q + 1) + (xcd - r) * q) + off; }
        const int nig = WGM * nN, gid = wgid / nig, fm = gid * WGM, gsz = (nM - fm) < WGM ? (nM - fm) : WGM;
        pm = fm + ((wgid % nig) % gsz); pn = (wgid % nig) / gsz; return true;
    }
};

template <class Epi, class Sched>
__device__ __forceinline__ void gemm_phase(LAS unsigned char* lds, const int K, const Sched& S, const Epi& E) {
    const int tid = threadIdx.x, wid = __builtin_amdgcn_readfirstlane(tid >> 6), lane = tid & 63, wr = wid >> 2, wc = wid & 3, fr = lane & 15, fq = lane >> 4;
    const int nt = K / BK;
    unsigned voffA[2], vbR[2], vbC[2];
#pragma unroll
    for (int i = 0; i < 2; ++i) { int R, C; stage_rc(tid * 16 + i * 8192, R, C); const int Rb = Epi::PERM ? ((R & ~31) + perm32(R & 31)) : R;
        voffA[i] = (unsigned)(R * K + C) * 2u; vbR[i] = (unsigned)(Rb * K) * 2u; vbC[i] = (unsigned)C * 2u; }
    const size_t kstep = (size_t)(BK * 2);
    const size_t hstep = (size_t)HALF * K * 2;
    const unsigned ldsw = (unsigned)wid * 1024u;
    const int aoff = lds_byte(wr * 64 + fr, fq * 8), boff = lds_byte(wc * 32 + fr, fq * 8);
#define PG8_SA(b, h) (((b) * 2 + (h)) * HTB)
#define PG8_SB(b, h) ((4 + (b) * 2 + (h)) * HTB)
#define PG8_STAGE(bufoff, gbase, voff) do { _Pragma("unroll") for (int _i = 0; _i < 2; ++_i) \
        __builtin_amdgcn_global_load_lds((const unsigned*)((const char*)(gbase) + (voff)[_i]), (LAS unsigned*)(lds + (bufoff) + ldsw + _i * 8192), 16, 0, 0); } while (0)
#define PG8_LDA(dst, b, h) do { _Pragma("unroll") for (int m = 0; m < 4; ++m) _Pragma("unroll") for (int k = 0; k < 2; ++k) dst[m][k] = *(const LAS bf16x8*)(lds + PG8_SA(b, h) + aoff + m * 2048 + k * 1024); } while (0)
#define PG8_LDB(dst, b, h) do { _Pragma("unroll") for (int n = 0; n < 2; ++n) _Pragma("unroll") for (int k = 0; k < 2; ++k) dst[n][k] = *(const LAS bf16x8*)(lds + PG8_SB(b, h) + boff + n * 2048 + k * 1024); } while (0)
#define PG8_MMA(ai, bj, At, Bt) do { __builtin_amdgcn_s_setprio(1); _Pragma("unroll") for (int m = 0; m < 4; ++m) _Pragma("unroll") for (int n = 0; n < 2; ++n) _Pragma("unroll") for (int k = 0; k < 2; ++k) \
        acc[ai][bj][m][n] = __builtin_amdgcn_mfma_f32_16x16x32_bf16(Bt[n][k], At[m][k], acc[ai][bj][m][n], 0, 0, 0); __builtin_amdgcn_s_setprio(0); } while (0)
#define PG8_WAIT_V(n) asm volatile("s_waitcnt vmcnt(" #n ")" ::: "memory")
#define PG8_WAIT_L(n) asm volatile("s_waitcnt lgkmcnt(" #n ")" ::: "memory")
#define PG8_BAR __builtin_amdgcn_s_barrier()
#define PG8_SCHED __builtin_amdgcn_sched_barrier(0)
    Unit cur, nxt; int ui = 0;
    if (!S.next(0, cur)) return;
    f32x4 acc[2][2][4][2];
#pragma unroll
    for (int a = 0; a < 2; ++a)
#pragma unroll
        for (int b = 0; b < 2; ++b)
#pragma unroll
            for (int m = 0; m < 4; ++m)
#pragma unroll
                for (int n = 0; n < 2; ++n) acc[a][b][m][n] = (f32x4){0.f, 0.f, 0.f, 0.f};
    bf16x8 At[4][2], B0[2][2], B1[2][2];
    const char* cA; const char* cB; int cd;
    S.locate(cur, cA, cB, cd);
    size_t hstepB = hstep * (size_t)cd;
    {
    unsigned voffB[2] = {vbR[0] * (unsigned)cd + vbC[0], vbR[1] * (unsigned)cd + vbC[1]};
    PG8_STAGE(PG8_SB(0, 0), cB, voffB); PG8_STAGE(PG8_SB(0, 1), cB + hstepB, voffB); PG8_STAGE(PG8_SA(0, 0), cA, voffA); PG8_STAGE(PG8_SA(0, 1), cA + hstep, voffA);
    if (wr == 1) PG8_BAR;
    PG8_WAIT_V(2); PG8_BAR;
    PG8_STAGE(PG8_SB(1, 0), cB + kstep, voffB); PG8_STAGE(PG8_SA(1, 0), cA + kstep, voffA); PG8_STAGE(PG8_SB(1, 1), cB + hstepB + kstep, voffB);
    PG8_WAIT_V(6); PG8_BAR;
    }
    for (;;) {
        const bool has_next = S.next(ui + 1, nxt);
        const char* nA = cA; const char* nB = cB; int nd = cd;
        if (has_next) S.locate(nxt, nA, nB, nd);
        const size_t nhstepB = hstep * (size_t)nd;
        for (int t = 0; t < nt; t += 2) {
            const bool last = (t == nt - 2);
            if constexpr (Epi::HOOK_T >= 0) { if (t == Epi::HOOK_T) { int t2 = threadIdx.x; asm volatile("" : "+v"(t2)); E.hook(acc, cur, (t2 >> 8) & 1, (t2 >> 6) & 3, t2 & 15, (t2 >> 4) & 3); } }
            const char* a1 = cA + (size_t)(t + 1) * kstep;
            const char* a2 = last ? nA : cA + (size_t)(t + 2) * kstep; const char* b2 = last ? nB : cB + (size_t)(t + 2) * kstep;
            const char* a3 = a2 + kstep; const char* b3 = b2 + kstep;
            const unsigned dsel = (unsigned)(last ? nd : cd);
            unsigned vB2[2] = {vbR[0] * dsel + vbC[0], vbR[1] * dsel + vbC[1]};
            const size_t hB2 = last ? nhstepB : hstepB;
            PG8_LDB(B0, 0, 0); PG8_LDB(B1, 0, 1); PG8_SCHED; PG8_LDA(At, 0, 0); PG8_STAGE(PG8_SA(1, 1), a1 + hstep, voffA);
            PG8_WAIT_V(8); PG8_WAIT_L(0); PG8_BAR; PG8_MMA(0, 0, At, B0); PG8_MMA(0, 1, At, B1); PG8_BAR; PG8_SCHED;
            PG8_LDA(At, 0, 1); PG8_STAGE(PG8_SB(0, 0), b2, vB2); PG8_STAGE(PG8_SB(0, 1), b2 + hB2, vB2); PG8_STAGE(PG8_SA(0, 0), a2, voffA);
            PG8_WAIT_V(8); PG8_WAIT_L(0); PG8_BAR; PG8_MMA(1, 0, At, B0); PG8_MMA(1, 1, At, B1); PG8_BAR; PG8_SCHED;
            PG8_LDB(B0, 1, 0); PG8_LDB(B1, 1, 1); PG8_SCHED; PG8_LDA(At, 1, 0); PG8_STAGE(PG8_SA(0, 1), a2 + hstep, voffA);
            PG8_WAIT_V(8); PG8_WAIT_L(0); PG8_BAR; PG8_MMA(0, 0, At, B0); PG8_MMA(0, 1, At, B1); PG8_BAR; PG8_SCHED;
            PG8_LDA(At, 1, 1); PG8_STAGE(PG8_SB(1, 0), b3, vB2); PG8_STAGE(PG8_SB(1, 1), b3 + hB2, vB2); PG8_STAGE(PG8_SA(1, 0), a3, voffA);
            PG8_WAIT_V(8); PG8_WAIT_L(0); PG8_BAR; PG8_MMA(1, 0, At, B0); PG8_MMA(1, 1, At, B1); PG8_BAR; PG8_SCHED;
        }
        if (wr == 0) PG8_BAR;
        { int t2 = threadIdx.x; asm volatile("" : "+v"(t2)); E(acc, cur, (t2 >> 8) & 1, (t2 >> 6) & 3, t2 & 15, (t2 >> 4) & 3); }
        if (!has_next) break;
#pragma unroll
        for (int a = 0; a < 2; ++a)
#pragma unroll
            for (int b = 0; b < 2; ++b)
#pragma unroll
                for (int m = 0; m < 4; ++m)
#pragma unroll
                    for (int n = 0; n < 2; ++n) acc[a][b][m][n] = (f32x4){0.f, 0.f, 0.f, 0.f};
        cur = nxt; cA = nA; cB = nB; cd = nd; hstepB = nhstepB; ++ui;
        if (wr == 1) PG8_BAR;
    }
    PG8_WAIT_V(0);
    PG8_BAR;
#undef PG8_SA
#undef PG8_SB
#undef PG8_STAGE
#undef PG8_LDA
#undef PG8_LDB
#undef PG8_MMA
#undef PG8_WAIT_V
#undef PG8_WAIT_L
#undef PG8_BAR
#undef PG8_SCHED
}
}
using pg8::Unit;

__device__ __forceinline__ u32x4 pack8(const f32x4 a, const f32x4 b) { u32x4 w; w.x = cvt_pk(a[0], a[1]); w.y = cvt_pk(a[2], a[3]); w.z = cvt_pk(b[0], b[1]); w.w = cvt_pk(b[2], b[3]); return w; }

struct SchedIn {
    pg8::Order o; int part; const char* XB; const char* WIN;
    __device__ __forceinline__ bool next(int i, Unit& u) const {
        int pm, vn; if (!o.raw(i, pm, vn)) return false;
        if (part == 0) {
            if (vn < 12) { u.type = 0; u.pm = pm; u.pn = vn; }
            else if (vn < 26) { u.type = 0; u.pm = pm; u.pn = vn + 8; }
            else { u.type = 1; u.pm = vn - 26; u.pn = pm; }
        } else {
            u.type = 0; u.pm = pm; u.pn = vn < 2 ? 34 + vn : (vn < 4 ? 16 + vn : 32 + vn);
        }
        return true;
    }
    __device__ __forceinline__ void locate(const Unit& u, const char*& A, const char*& B, int& dB) const {
        if (u.type == 0) { A = XB + (size_t)u.pm * 256 * D * 2; B = WIN + (size_t)u.pn * 256 * D * 2; dB = 1; }
        else { const int g = u.pm >> 1, dsh = 2 * g, b0 = u.pn * 256, r = b0 >> (14 - dsh), l0 = b0 & ((16384 >> dsh) - 1);
               A = WIN + (size_t)(12 + u.pm) * 256 * D * 2; B = XB + (size_t)((l0 << dsh) + r) * D * 2; dB = 1 << dsh; }
    }
};
struct EpiIn {
    static constexpr bool PERM = true; static constexpr int HOOK_T = -1;
    bf16_t *QK, *VT, *SG, *U, *P, *RATIO, *GA; const float* b_gate;
    __device__ __forceinline__ void hook(f32x4 (&)[2][2][4][2], const Unit&, int, int, int, int) const {}
    __device__ __forceinline__ void operator()(const f32x4 (&acc)[2][2][4][2], const Unit& u, int wr, int wc, int fr, int fq) const {
        const int cl = wc * 32 + 8 * fq;
        if (u.type == 1) {
            bf16_t* base = VT + (size_t)(u.pm * 256 + wr * 64 + fr) * S + u.pn * 256 + cl;
#pragma unroll
            for (int ai = 0; ai < 2; ++ai)
#pragma unroll
                for (int m = 0; m < 4; ++m) { bf16_t* rowp = base + (size_t)(ai * 128 + m * 16) * S;
#pragma unroll
                    for (int bj = 0; bj < 2; ++bj) *(u32x4*)(rowp + bj * 128) = pack8(acc[ai][bj][m][0], acc[ai][bj][m][1]); }
            return;
        }
        const int row0 = u.pm * 256 + wr * 64 + fr, wt = u.pn;
        if (wt < 12) {
            const float sc = wt < 6 ? C2 : 1.0f;
            bf16_t* base = QK + (size_t)row0 * 3072 + wt * 256 + cl;
#pragma unroll
            for (int ai = 0; ai < 2; ++ai)
#pragma unroll
                for (int m = 0; m < 4; ++m) { bf16_t* rowp = base + (size_t)(ai * 128 + m * 16) * 3072;
#pragma unroll
                    for (int bj = 0; bj < 2; ++bj) *(u32x4*)(rowp + bj * 128) = pack8(acc[ai][bj][m][0] * sc, acc[ai][bj][m][1] * sc); }
        } else if (wt < 20) {
            bf16_t* base = SG + (size_t)row0 * AW + (wt - 18) * 256 + cl;
#pragma unroll
            for (int ai = 0; ai < 2; ++ai)
#pragma unroll
                for (int m = 0; m < 4; ++m) { bf16_t* rowp = base + (size_t)(ai * 128 + m * 16) * AW;
#pragma unroll
                    for (int bj = 0; bj < 2; ++bj) { f32x4 v0 = acc[ai][bj][m][0], v1 = acc[ai][bj][m][1];
#pragma unroll
                        for (int j = 0; j < 4; ++j) { v0[j] = siluf_(v0[j]); v1[j] = siluf_(v1[j]); }
                        *(u32x4*)(rowp + bj * 128) = pack8(v0, v1); } }
        } else if (wt < 36) {
            const bool isU = wt < 28;
            bf16_t* base = (isU ? U + (size_t)(wt - 20) * 128 : P + (size_t)(wt - 28) * 128) + (size_t)row0 * D + cl;
#pragma unroll
            for (int ai = 0; ai < 2; ++ai)
#pragma unroll
                for (int m = 0; m < 4; ++m) { bf16_t* rowp = base + (size_t)(ai * 128 + m * 16) * D;
                    f32x4 v0 = acc[ai][1][m][0], v1 = acc[ai][1][m][1];
                    if (!isU) {
#pragma unroll
                        for (int j = 0; j < 4; ++j) { v0[j] = siluf_(v0[j]); v1[j] = siluf_(v1[j]); } }
                    v0 = v0 * acc[ai][0][m][0]; v1 = v1 * acc[ai][0][m][1];
                    *(u32x4*)rowp = pack8(v0, v1); }
        } else {
            const int ch = (wt - 36) * 128 + cl;
            const f32x4 bc0 = *(const f32x4*)(b_gate + ch), bc1 = *(const f32x4*)(b_gate + ch + 4), ba0 = *(const f32x4*)(b_gate + D + ch), ba1 = *(const f32x4*)(b_gate + D + ch + 4);
#pragma unroll
            for (int ai = 0; ai < 2; ++ai)
#pragma unroll
                for (int m = 0; m < 4; ++m) { const size_t off = (size_t)(row0 + ai * 128 + m * 16) * D + ch;
                    f32x4 c0 = acc[ai][0][m][0] + bc0, c1 = acc[ai][0][m][1] + bc1, a0 = acc[ai][1][m][0] + ba0, a1 = acc[ai][1][m][1] + ba1;
                    f32x4 r0, r1, g0, g1;
#pragma unroll
                    for (int j = 0; j < 4; ++j) { const float ea0 = 1.0f + __expf(-a0[j]), ea1 = 1.0f + __expf(-a1[j]);
                        g0[j] = __builtin_amdgcn_rcpf(ea0); g1[j] = __builtin_amdgcn_rcpf(ea1);
                        r0[j] = ea0 * sigmoidf_(c0[j]); r1[j] = ea1 * sigmoidf_(c1[j]); }
                    *(u32x4*)(RATIO + off) = pack8(r0, r1); *(u32x4*)(GA + off) = pack8(g0, g1); }
        }
    }
};

struct SchedPlain {
    pg8::Order o; const char* A; const char* Bt; int K;
    __device__ __forceinline__ bool next(int i, Unit& u) const { u.type = 0; return o.raw(i, u.pm, u.pn); }
    __device__ __forceinline__ void locate(const Unit& u, const char*& a, const char*& b, int& dB) const { a = A + (size_t)u.pm * 256 * K * 2; b = Bt + (size_t)u.pn * 256 * K * 2; dB = 1; }
};
struct EpiY {
    static constexpr bool PERM = true; static constexpr int HOOK_T = 16;
    const bf16_t *RATIO, *GA; bf16_t* MERGED;
    __device__ __forceinline__ void hook(f32x4 (&acc)[2][2][4][2], const Unit& u, int wr, int wc, int fr, int fq) const {
        const bf16_t* base = RATIO + (size_t)(u.pm * 256 + wr * 64 + fr) * D + u.pn * 256 + wc * 32 + 8 * fq;
#pragma unroll
        for (int ai = 0; ai < 2; ++ai) {
#pragma unroll
            for (int m = 0; m < 4; ++m)
#pragma unroll
                for (int bj = 0; bj < 2; ++bj) { const u32x4 w = *(const u32x4*)(base + (size_t)(ai * 128 + m * 16) * D + bj * 128);
                    acc[ai][bj][m][0] = acc[ai][bj][m][0] * (f32x4){bf_lo(w.x), bf_hi(w.x), bf_lo(w.y), bf_hi(w.y)};
                    acc[ai][bj][m][1] = acc[ai][bj][m][1] * (f32x4){bf_lo(w.z), bf_hi(w.z), bf_lo(w.w), bf_hi(w.w)}; }
            asm volatile("" ::: "memory");
        }
    }
    __device__ __forceinline__ void operator()(const f32x4 (&acc)[2][2][4][2], const Unit& u, int wr, int wc, int fr, int fq) const {
        const size_t off0 = (size_t)(u.pm * 256 + wr * 64 + fr) * D + u.pn * 256 + wc * 32 + 8 * fq;
#pragma unroll
        for (int ai = 0; ai < 2; ++ai) {
#pragma unroll
            for (int m = 0; m < 4; ++m)
#pragma unroll
                for (int bj = 0; bj < 2; ++bj) { const size_t off = off0 + (size_t)(ai * 128 + m * 16) * D + bj * 128; const u32x4 w = *(const u32x4*)(GA + off);
                    const f32x4 v0 = acc[ai][bj][m][0] * (f32x4){bf_lo(w.x), bf_hi(w.x), bf_lo(w.y), bf_hi(w.y)};
                    const f32x4 v1 = acc[ai][bj][m][1] * (f32x4){bf_lo(w.z), bf_hi(w.z), bf_lo(w.w), bf_hi(w.w)};
                    *(u32x4*)(MERGED + off) = pack8(v0, v1); }
            asm volatile("" ::: "memory");
        }
    }
};
struct EpiO {
    static constexpr bool PERM = false; static constexpr int HOOK_T = -1;
    const float* x; float* out;
    __device__ __forceinline__ void hook(f32x4 (&)[2][2][4][2], const Unit&, int, int, int, int) const {}
    __device__ __forceinline__ void operator()(const f32x4 (&acc)[2][2][4][2], const Unit& u, int wr, int wc, int fr, int fq) const {
        const size_t off0 = (size_t)(u.pm * 256 + wr * 64 + fr) * D + u.pn * 256 + wc * 32 + 4 * fq;
#pragma unroll
        for (int ai = 0; ai < 2; ++ai)
#pragma unroll
            for (int m = 0; m < 4; ++m)
#pragma unroll
                for (int bj = 0; bj < 2; ++bj)
#pragma unroll
                    for (int n = 0; n < 2; ++n) { const size_t off = off0 + (size_t)(ai * 128 + m * 16) * D + bj * 128 + n * 16;
                        const f32x4 xv = *(const f32x4*)(x + off); *(f32x4*)(out + off) = xv * DN_ALPHA + acc[ai][bj][m][n]; }
    }
};

__device__ __forceinline__ unsigned f2bf(float f) { unsigned u = __builtin_bit_cast(unsigned, f); return (u + 0x7fffu + ((u >> 16) & 1u)) >> 16; }
__device__ __forceinline__ unsigned pk2(float lo, float hi) { return f2bf(lo) | (f2bf(hi) << 16); }
__device__ __forceinline__ void p0_transpose_item(const float* W, int N, bf16_t* WT, int ldk, int koff, int drow, int k0, int n0, LAS float* scr, int lane) {
#pragma unroll 8
    for (int i = 0; i < 32; ++i) { const int kk = 2 * i + (lane >> 5); scr[kk * 33 + (lane & 31)] = W[(size_t)(k0 + kk) * N + n0 + (lane & 31)]; }
    asm volatile("s_waitcnt lgkmcnt(0)" ::: "memory");
    const int c = lane & 7;
#pragma unroll
    for (int j = 0; j < 4; ++j) { const int n = (lane >> 3) + 8 * j; const LAS float* s = scr + (8 * c) * 33 + n;
        u32x4 o; o.x = pk2(s[0 * 33], s[1 * 33]); o.y = pk2(s[2 * 33], s[3 * 33]); o.z = pk2(s[4 * 33], s[5 * 33]); o.w = pk2(s[6 * 33], s[7 * 33]);
        *(u32x4*)(WT + (size_t)(drow + n) * ldk + koff + k0 + 8 * c) = o; }
    asm volatile("s_waitcnt lgkmcnt(0)" ::: "memory");
}
__device__ __forceinline__ int drow_win(int n) {
    if (n < 5120) return n;
    const int sec = (n - 5120) >> 10, c = (n - 5120) & 1023;
    const int base = (sec == 0 || sec == 2) ? 5120 : ((sec == 1 || sec == 3) ? 7168 : 9216);
    const int half = (sec == 2 || sec == 3 || sec == 5) ? 1 : 0;
    return base + (c >> 7) * 256 + half * 128 + (c & 127);
}

__device__ __forceinline__ void attn_unit(int u, const bf16_t* __restrict__ QK, const bf16_t* __restrict__ VT, bf16_t* __restrict__ OG, float* __restrict__ LSE, int wid, int lane) {
    const int g = u >> 9, rem = u & 511, h = rem >> 6, blk = rem & 63;
    const int dsh = 2 * g, L = 16384 >> dsh;
    const int b0 = blk * 256, r = b0 >> (14 - dsh), l0 = b0 & (L - 1);
    const int lq0 = l0 + 32 * wid;
    const int q = lane & 31, hh = lane >> 5;
    const int colq = g * 512 + h * 64;
    const bf16_t* qp = QK + (size_t)(((lq0 + q) << dsh) + r) * 3072 + colq + 8 * hh;
    bf16x8 qf[4];
#pragma unroll
    for (int ks = 0; ks < 4; ++ks) qf[ks] = *(const bf16x8*)(qp + 16 * ks);
    const int pi = (q & 19) | ((q & 4) << 1) | ((q & 8) >> 1);
    const bool first = (l0 == 0);
    f32x16 s[5];
#pragma unroll
    for (int c = 0; c < 5; ++c) {
        const bool valid = !(first && (wid + c < 4));
        if (valid) {
            const int kl = lq0 - 128 + 32 * c + pi;
            const bf16_t* kp = QK + (size_t)((kl << dsh) + r) * 3072 + QKVW + colq + 8 * hh;
            f32x16 a = {0.f, 0.f, 0.f, 0.f, 0.f, 0.f, 0.f, 0.f, 0.f, 0.f, 0.f, 0.f, 0.f, 0.f, 0.f, 0.f};
#pragma unroll
            for (int ks = 0; ks < 4; ++ks) { const bf16x8 kf = *(const bf16x8*)(kp + 16 * ks); a = __builtin_amdgcn_mfma_f32_32x32x16_bf16(kf, qf[ks], a, 0, 0, 0); }
            s[c] = a;
        } else {
#pragma unroll
            for (int i = 0; i < 16; ++i) s[c][i] = -INFINITY;
        }
    }
#pragma unroll
    for (int i = 0; i < 16; ++i) { const int ko = 16 * (i >> 3) + 8 * hh + (i & 7); if (ko < q) s[0][i] = -INFINITY; if (ko > q) s[4][i] = -INFINITY; }
    float m = -INFINITY;
#pragma unroll
    for (int c = 0; c < 5; ++c)
#pragma unroll
        for (int i = 0; i < 16; ++i) m = fmaxf(m, s[c][i]);
    m = fmaxf(m, __shfl_xor(m, 32));
    float l = 0.f;
#pragma unroll
    for (int c = 0; c < 5; ++c)
#pragma unroll
        for (int i = 0; i < 16; ++i) { const float p = __builtin_amdgcn_exp2f(s[c][i] - m); s[c][i] = p; l += p; }
    l += __shfl_xor(l, 32);
    f32x16 o[2];
#pragma unroll
    for (int e = 0; e < 2; ++e)
#pragma unroll
        for (int i = 0; i < 16; ++i) o[e][i] = 0.f;
    const bf16_t* vp = VT + (size_t)(colq + q) * S + (size_t)r * L + lq0 - 128 + 8 * hh;
#pragma unroll
    for (int c = 0; c < 5; ++c) {
        const bool valid = !(first && (wid + c < 4));
        if (valid) {
#pragma unroll
            for (int st = 0; st < 2; ++st) {
                u32x4 pw; pw.x = cvt_pk(s[c][8 * st + 0], s[c][8 * st + 1]); pw.y = cvt_pk(s[c][8 * st + 2], s[c][8 * st + 3]); pw.z = cvt_pk(s[c][8 * st + 4], s[c][8 * st + 5]); pw.w = cvt_pk(s[c][8 * st + 6], s[c][8 * st + 7]);
                const bf16x8 pf = __builtin_bit_cast(bf16x8, pw);
#pragma unroll
                for (int e = 0; e < 2; ++e) { const bf16x8 vf = *(const bf16x8*)(vp + (size_t)(32 * e) * S + 32 * c + 16 * st);
                    o[e] = __builtin_amdgcn_mfma_f32_32x32x16_bf16(vf, pf, o[e], 0, 0, 0); }
            }
        }
    }
    const float inv = 1.0f / l, lse2 = m + __builtin_amdgcn_logf(l);
    const int token = ((lq0 + q) << dsh) + r;
    bf16_t* op = OG + ((size_t)g * S + token) * AW + h * 64 + 4 * hh;
#pragma unroll
    for (int e = 0; e < 2; ++e)
#pragma unroll
        for (int a = 0; a < 4; ++a) { u32x2 w; w.x = cvt_pk(o[e][4 * a] * inv, o[e][4 * a + 1] * inv); w.y = cvt_pk(o[e][4 * a + 2] * inv, o[e][4 * a + 3] * inv);
            *(u32x2*)(op + 32 * e + 8 * a) = w; }
    if (hh == 0) LSE[((size_t)g * S + token) * 8 + h] = lse2;
}

#define XB_TMO      128
#define XB_XCNT(j)  (256  + 64 * (j))
#define XB_XSUB(j)  (1280 + 64 * (j))
#define XB_XGEN(j)  (2304 + 64 * (j))
#define XB_TOP      3328
#define XB_TOPGEN   3392
#define XCD_BAR_WORDS 3456
#define XB_SPIN_CAP (1u << 18)
__device__ __forceinline__ unsigned xb_ld(unsigned* p)              { return __hip_atomic_load(p, __ATOMIC_RELAXED, __HIP_MEMORY_SCOPE_AGENT); }
__device__ __forceinline__ unsigned xb_add(unsigned* p, unsigned v) { return __hip_atomic_fetch_add(p, v, __ATOMIC_RELAXED, __HIP_MEMORY_SCOPE_AGENT); }
__device__ __forceinline__ unsigned xb_xcc_id() { return (unsigned)__builtin_amdgcn_s_getreg((3 << 11) | 20) & 0xFu; }
#define XB_SPIN(cond, bar) do { unsigned _sp = 0; while (cond) { __builtin_amdgcn_s_sleep(1); \
    if ((++_sp & 255u) == 0u) { if (xb_ld(&(bar)[XB_TMO])) break; if (_sp > XB_SPIN_CAP) { atomicAdd(&(bar)[XB_TMO], 1u); break; } } } } while (0)
struct XcdBarrier { unsigned* bar; unsigned x; volatile LAS unsigned* st; };
__device__ __forceinline__ XcdBarrier xcd_barrier_post(unsigned* bar, volatile LAS unsigned* st) {
    XcdBarrier b; b.bar = bar; b.x = xb_xcc_id(); b.st = st;
    if (threadIdx.x == 0) (void)xb_add(&bar[XB_XCNT(b.x)], 1u);
    return b;
}
__device__ __forceinline__ void xcd_barrier_complete(unsigned* bar, unsigned x, unsigned& nloc, unsigned& nx) {
    const unsigned G = gridDim.x * gridDim.y * gridDim.z;
    unsigned sum, cnt, mine, sp = 0u;
    for (;;) {
        sum = 0u; cnt = 0u; mine = 0u;
#pragma unroll
        for (unsigned j = 0; j < 16; ++j) { const unsigned c = xb_ld(&bar[XB_XCNT(j)]); sum += c; cnt += (c > 0u) ? 1u : 0u; mine = (j == x) ? c : mine; }
        if (sum == G) break;
        __builtin_amdgcn_s_sleep(1);
        if ((++sp & 255u) == 0u) { if (xb_ld(&bar[XB_TMO])) break; if (sp > XB_SPIN_CAP) { atomicAdd(&bar[XB_TMO], 1u); break; } }
    }
    nloc = mine > 0u ? mine : 1u; nx = cnt > 0u ? cnt : 1u;
}
__device__ __forceinline__ void xcd_barrier(const XcdBarrier& b) {
    asm volatile("s_waitcnt vmcnt(0)" ::: "memory");
    __syncthreads();
    if (threadIdx.x == 0) {
        unsigned* bar = b.bar;
        __builtin_amdgcn_s_waitcnt(0);
        unsigned nloc = b.st[0], nx = b.st[1];
        if (nloc == 0u) { xcd_barrier_complete(bar, b.x, nloc, nx); b.st[0] = nloc; b.st[1] = nx; }
        const unsigned old = xb_add(&bar[XB_XSUB(b.x)], 1u);
        const unsigned gen = old / nloc;
        if (old + 1u == (gen + 1u) * nloc) {
            __builtin_amdgcn_fence(__ATOMIC_RELEASE, "agent");
            asm volatile("s_waitcnt vmcnt(0)" ::: "memory");
            const unsigned og = xb_add(&bar[XB_TOP], 1u);
            const unsigned tg = og / nx;
            if (og + 1u == (tg + 1u) * nx) xb_add(&bar[XB_TOPGEN], 1u);
            else XB_SPIN(xb_ld(&bar[XB_TOPGEN]) == tg, bar);
            __builtin_amdgcn_fence(__ATOMIC_ACQUIRE, "agent");
            xb_add(&bar[XB_XGEN(b.x)], 1u);
            asm volatile("s_waitcnt vmcnt(0)" ::: "memory");
        } else {
            XB_SPIN(xb_ld(&bar[XB_XGEN(b.x)]) == gen, bar);
            __builtin_amdgcn_fence(__ATOMIC_ACQUIRE, "agent");
            asm volatile("s_waitcnt vmcnt(0)" ::: "memory");
        }
    }
    __syncthreads();
}

constexpr int RING_BYTES = 131072, LDS_BYTES = 147456;
struct Args { const float* in[9]; float* out; unsigned char* ws; int lo, hi; };

__device__ __forceinline__ float wave_sum(float v) {
#pragma unroll
    for (int o = 1; o < 64; o <<= 1) v += __shfl_xor(v, o);
    return v;
}

__global__ void __launch_bounds__(512, 2) fwd(Args a) {
    extern __shared__ __attribute__((aligned(16))) unsigned char lds_raw[];
    LAS unsigned char* lds = (LAS unsigned char*)lds_raw;
    const int tid = threadIdx.x, lane = tid & 63, wave = __builtin_amdgcn_readfirstlane(tid >> 6);
    const int G = gridDim.x, bx = blockIdx.x;
    const int vcu = (G % 8 == 0) ? (bx % 8) * (G / 8) + bx / 8 : bx;
    const int gw = vcu * 8 + wave, NGW = G * 8;
#define PTRS() \
    const float* x = a.in[0]; const float* w_in = a.in[1]; const float* conv_w = a.in[2]; const float* w_co = a.in[3]; const float* w_ao = a.in[4]; \
    const float* b_gate = a.in[5]; const float* w_o = a.in[6]; const float* ln_g = a.in[7]; const float* ln_b = a.in[8]; \
    unsigned char* ws = a.ws; float* out = a.out; \
    bf16_t* XB = (bf16_t*)(ws + WS_XB); bf16_t* WIN = (bf16_t*)(ws + WS_WIN); bf16_t* WY = (bf16_t*)(ws + WS_WY); bf16_t* WO = (bf16_t*)(ws + WS_WO); \
    bf16_t* QK = (bf16_t*)(ws + WS_QK); bf16_t* VT = (bf16_t*)(ws + WS_VT); bf16_t* OG = (bf16_t*)(ws + WS_OG); float* LSE = (float*)(ws + WS_LSE); \
    bf16_t* SG = (bf16_t*)(ws + WS_SG); bf16_t* RATIO = (bf16_t*)(ws + WS_RATIO); bf16_t* GA = (bf16_t*)(ws + WS_GA); bf16_t* A2 = (bf16_t*)(ws + WS_A2); \
    bf16_t* MERGED = (bf16_t*)(ws + WS_MERGED); \
    bf16_t* U = (bf16_t*)out; bf16_t* P = (bf16_t*)out + (size_t)S * D; \
    (void)x; (void)w_in; (void)conv_w; (void)w_co; (void)w_ao; (void)b_gate; (void)w_o; (void)ln_g; (void)ln_b; (void)XB; (void)WIN; (void)WY; (void)WO; (void)QK; (void)VT; (void)OG; (void)LSE; \
    (void)SG; (void)RATIO; (void)GA; (void)A2; (void)MERGED; (void)U; (void)P;
    const int lo = a.lo, hi = a.hi;
#define IN(k) (lo <= (k) && (k) < hi)
    volatile LAS unsigned* MISC = (volatile LAS unsigned*)(lds + RING_BYTES + 256);
    if (tid < 8) MISC[tid] = 0u;
    __syncthreads();
    XcdBarrier bar = xcd_barrier_post((unsigned*)(a.ws + WS_CTL), MISC);
    if (a.hi > 1000) cg::this_grid().sync();
#define SEAM(k) do { if (IN(k) && IN((k) + 1)) { xcd_barrier(bar); } } while (0)

    if (IN(0)) for (int rep_ = 0; rep_ < ((DUP_PHASE == 0) ? 2 : 1); ++rep_) {
        PTRS();
        for (size_t i = (size_t)bx * 512 + tid; i < (size_t)S * D / 8; i += (size_t)G * 512) {
            const f32x4 v0 = *(const f32x4*)(x + i * 8), v1 = *(const f32x4*)(x + i * 8 + 4);
            *(u32x4*)(XB + i * 8) = pack8(v0, v1);
        }
        LAS float* scr = (LAS float*)(lds + wave * 16384);
        constexpr int I_IN = 16 * (NIN / 32), I_CO = 16 * 32, I_AO = 8 * 32, I_O = 16 * 32, NITEMS = I_IN + I_CO + I_AO + I_O;
        for (int it = gw; it < NITEMS; it += NGW) {
            int r = it;
            if (r < I_IN) { const int kb = r / (NIN / 32), nb = r % (NIN / 32); p0_transpose_item(w_in, NIN, WIN, D, 0, drow_win(nb * 32), kb * 64, nb * 32, scr, lane); continue; } r -= I_IN;
            if (r < I_CO) { const int kb = r / 32, nb = r % 32; p0_transpose_item(w_co, D, WY, 1536, 0, nb * 32, kb * 64, nb * 32, scr, lane); continue; } r -= I_CO;
            if (r < I_AO) { const int kb = r / 32, nb = r % 32; p0_transpose_item(w_ao, D, WY, 1536, 1024, nb * 32, kb * 64, nb * 32, scr, lane); continue; } r -= I_AO;
            { const int kb = r / 32, nb = r % 32; p0_transpose_item(w_o, D, WO, D, 0, nb * 32, kb * 64, nb * 32, scr, lane); }
        }
        __syncthreads();
    }
    SEAM(0);

    if (IN(1)) for (int rep_ = 0; rep_ < ((DUP_PHASE == 1) ? 2 : 1); ++rep_) {
        PTRS();
        SchedIn Sc; Sc.o.init(64, 32, G, bx); Sc.part = 0; Sc.XB = (const char*)XB; Sc.WIN = (const char*)WIN;
        EpiIn E{QK, VT, SG, U, P, RATIO, GA, b_gate};
        pg8::gemm_phase<EpiIn, SchedIn>(lds, D, Sc, E);
    }
    SEAM(1);

    if (IN(2)) for (int rep_ = 0; rep_ < ((DUP_PHASE == 2) ? 2 : 1); ++rep_) {
        PTRS();
        for (int u = vcu; u < 1536; u += G) attn_unit(u, QK, VT, OG, LSE, wave, lane);
    }
    SEAM(2);

    if (IN(3)) for (int rep_ = 0; rep_ < ((DUP_PHASE == 3) ? 2 : 1); ++rep_) {
        PTRS();
        SchedIn Sc; Sc.o.init(64, 12, G, bx); Sc.part = 1; Sc.XB = (const char*)XB; Sc.WIN = (const char*)WIN;
        EpiIn E{QK, VT, SG, U, P, RATIO, GA, b_gate};
        pg8::gemm_phase<EpiIn, SchedIn>(lds, D, Sc, E);
    }
    SEAM(3);

    if (IN(4)) for (int rep_ = 0; rep_ < ((DUP_PHASE == 4) ? 2 : 1); ++rep_) {
        PTRS();
        for (size_t idx = (size_t)bx * 512 + tid; idx < (size_t)S * 192; idx += (size_t)G * 512) {
            const int t = (int)(idx / 192), c8 = (int)(idx % 192);
            if (c8 < 128) {
                const int ch = c8 * 8;
                const u32x4 pw = *(const u32x4*)(P + (size_t)t * D + ch);
                const u32x4 u0 = *(const u32x4*)(U + (size_t)t * D + ch);
                u32x4 u1 = {0u, 0u, 0u, 0u}, u2 = {0u, 0u, 0u, 0u};
                if (t >= 1) u1 = *(const u32x4*)(U + (size_t)(t - 1) * D + ch);
                if (t >= 2) u2 = *(const u32x4*)(U + (size_t)(t - 2) * D + ch);
                float r[8];
#pragma unroll
                for (int j = 0; j < 4; ++j) {
                    const unsigned wp = pw[j], w0 = u0[j], w1 = u1[j], w2 = u2[j];
                    const int c0 = ch + 2 * j, c1 = c0 + 1;
                    r[2 * j] = bf_lo(wp) * (conv_w[c0] * bf_lo(w2) + conv_w[D + c0] * bf_lo(w1) + conv_w[2 * D + c0] * bf_lo(w0));
                    r[2 * j + 1] = bf_hi(wp) * (conv_w[c1] * bf_hi(w2) + conv_w[D + c1] * bf_hi(w1) + conv_w[2 * D + c1] * bf_hi(w0));
                }
                u32x4 ov; ov.x = cvt_pk(r[0], r[1]); ov.y = cvt_pk(r[2], r[3]); ov.z = cvt_pk(r[4], r[5]); ov.w = cvt_pk(r[6], r[7]);
                *(u32x4*)(A2 + (size_t)t * 1536 + ch) = ov;
            } else {
                const int col = (c8 - 128) * 8, h = col >> 6;
                const float l0 = LSE[((size_t)0 * S + t) * 8 + h], l1 = LSE[((size_t)1 * S + t) * 8 + h], l2 = LSE[((size_t)2 * S + t) * 8 + h];
                const float mx = fmaxf(l0, fmaxf(l1, l2));
                float e0 = __builtin_amdgcn_exp2f(l0 - mx), e1 = __builtin_amdgcn_exp2f(l1 - mx), e2 = __builtin_amdgcn_exp2f(l2 - mx);
                const float inv = 1.0f / (e0 + e1 + e2); e0 *= inv; e1 *= inv; e2 *= inv;
                const u32x4 o0 = *(const u32x4*)(OG + ((size_t)0 * S + t) * AW + col), o1 = *(const u32x4*)(OG + ((size_t)1 * S + t) * AW + col), o2 = *(const u32x4*)(OG + ((size_t)2 * S + t) * AW + col);
                const u32x4 sg = *(const u32x4*)(SG + (size_t)t * AW + col);
                float r[8];
#pragma unroll
                for (int j = 0; j < 4; ++j) {
                    r[2 * j] = bf_lo(sg[j]) * (e0 * bf_lo(o0[j]) + e1 * bf_lo(o1[j]) + e2 * bf_lo(o2[j]));
                    r[2 * j + 1] = bf_hi(sg[j]) * (e0 * bf_hi(o0[j]) + e1 * bf_hi(o1[j]) + e2 * bf_hi(o2[j]));
                }
                u32x4 ov; ov.x = cvt_pk(r[0], r[1]); ov.y = cvt_pk(r[2], r[3]); ov.z = cvt_pk(r[4], r[5]); ov.w = cvt_pk(r[6], r[7]);
                *(u32x4*)(A2 + (size_t)t * 1536 + 1024 + col) = ov;
            }
        }
    }
    SEAM(4);

    if (IN(5)) for (int rep_ = 0; rep_ < ((DUP_PHASE == 5) ? 2 : 1); ++rep_) {
        PTRS();
        SchedPlain Sc; Sc.o.init(64, 4, G, bx); Sc.A = (const char*)A2; Sc.Bt = (const char*)WY; Sc.K = 1536;
        EpiY E{RATIO, GA, MERGED};
        pg8::gemm_phase<EpiY, SchedPlain>(lds, 1536, Sc, E);
    }
    SEAM(5);

    if (IN(6)) for (int rep_ = 0; rep_ < ((DUP_PHASE == 6) ? 2 : 1); ++rep_) {
        PTRS();
        SchedPlain Sc; Sc.o.init(64, 4, G, bx); Sc.A = (const char*)MERGED; Sc.Bt = (const char*)WO; Sc.K = D;
        EpiO E{x, out};
        pg8::gemm_phase<EpiO, SchedPlain>(lds, D, Sc, E);
    }
    SEAM(6);

    if (IN(7)) {
        PTRS();
        f32x4 gv[4], bv[4];
#pragma unroll
        for (int j = 0; j < 4; ++j) { gv[j] = *((const f32x4*)ln_g + lane + 64 * j); bv[j] = *((const f32x4*)ln_b + lane + 64 * j); }
        for (int mrow = gw; mrow < S; mrow += NGW) {
            f32x4* xr = (f32x4*)(out + (size_t)mrow * D) + lane;
            f32x4 v[4]; float s = 0.f;
#pragma unroll
            for (int j = 0; j < 4; ++j) { v[j] = xr[64 * j]; s += (v[j].x + v[j].y) + (v[j].z + v[j].w); }
            const float mean = wave_sum(s) * (1.f / D); float s2 = 0.f;
#pragma unroll
            for (int j = 0; j < 4; ++j) { v[j] = v[j] - mean; s2 += (v[j].x * v[j].x + v[j].y * v[j].y) + (v[j].z * v[j].z + v[j].w * v[j].w); }
            const float rstd = 1.f / sqrtf(wave_sum(s2) * (1.f / D) + LN_EPS);
#pragma unroll
            for (int j = 0; j < 4; ++j) xr[64 * j] = v[j] * rstd * gv[j] + bv[j];
        }
    }
#undef IN
#undef SEAM
}

extern "C" void kernel_launch(void* const* d_in, const int* in_sizes, int n_in, void* d_out, int out_size, void* d_ws, size_t ws_size, hipStream_t stream) {
    static int grid = 0;
    if (grid == 0) {
        if (n_in != 9 || in_sizes[0] != S * D || in_sizes[1] != D * NIN || out_size != S * D || ws_size < WS_END) {
            fprintf(stderr, "kernel_launch: unexpected shapes (n_in %d, in0 %d, in1 %d, out %d, ws %zu)\n", n_in, n_in > 0 ? in_sizes[0] : -1, n_in > 1 ? in_sizes[1] : -1, out_size, ws_size); grid = -1; return; }
        int dev = 0, cus = 0, per_cu = 0;
        hipGetDevice(&dev); hipDeviceGetAttribute(&cus, hipDeviceAttributeMultiprocessorCount, dev);
        hipFuncSetAttribute((const void*)fwd, hipFuncAttributeMaxDynamicSharedMemorySize, LDS_BYTES);
        hipOccupancyMaxActiveBlocksPerMultiprocessor(&per_cu, (const void*)fwd, 512, LDS_BYTES);
        if (per_cu < 1) { fprintf(stderr, "kernel_launch: occupancy query says %d blocks/CU\n", per_cu); per_cu = 1; }
        (void)hipGetLastError();
        grid = cus;
    }
    if (grid < 0) return;
    if (hipMemsetAsync((char*)d_ws + WS_CTL, 0, CTL_BYTES, stream) != hipSuccess) { fprintf(stderr, "kernel_launch: memset of the barrier words failed\n"); return; }
    Args a{};
    for (int i = 0; i < 9; ++i) a.in[i] = (const float*)d_in[i];
    a.out = (float*)d_out; a.ws = (unsigned char*)d_ws;
#if N_LAUNCH_MODE == 1
    a.lo = 0; a.hi = NPH;
    void* args[] = {&a};
    hipError_t e = hipLaunchCooperativeKernel((const void*)fwd, dim3(grid), dim3(512), args, LDS_BYTES, stream);
    if (e != hipSuccess) fprintf(stderr, "cooperative launch failed: %s (grid %d)\n", hipGetErrorString(e), grid);
#else
    for (int p = 0; p < NPH; ++p) { a.lo = p; a.hi = p + 1; hipLaunchKernelGGL(fwd, dim3(grid), dim3(512), LDS_BYTES, stream, a); }
#endif
}
```
